# Optimizing an MI355X kernel written in HIP

```python
import jax, jax.numpy as jnp
from jax import lax
import numpy as np

D_MODEL = 4096
BATCH = 2
SEQ = 8192
DEPTH = 1

N_META = 16
BLOCK = 128
WINDOW = 128
ATT_HEADS = 32
ATT_KV_HEADS = 4
ATT_HEAD_DIM = 64
ATT_GROUP = ATT_HEADS // ATT_KV_HEADS
ATT_WIDTH = ATT_HEADS * ATT_HEAD_DIM
ATT_KV_WIDTH = ATT_KV_HEADS * ATT_HEAD_DIM
RET_HEADS = 8
RET_QK_DIM = 256
RET_V_DIM = 256
RET_QK_WIDTH = RET_HEADS * RET_QK_DIM
RET_WIDTH = RET_HEADS * RET_V_DIM
MIX_WIDTH = ATT_WIDTH + RET_WIDTH
IN_WIDTH = ATT_WIDTH + 2 * ATT_KV_WIDTH + 2 * RET_QK_WIDTH + 2 * RET_WIDTH
SPLIT_OFFSETS = (
    ATT_WIDTH,
    ATT_WIDTH + ATT_KV_WIDTH,
    ATT_WIDTH + 2 * ATT_KV_WIDTH,
    ATT_WIDTH + 2 * ATT_KV_WIDTH + RET_QK_WIDTH,
    ATT_WIDTH + 2 * ATT_KV_WIDTH + 2 * RET_QK_WIDTH,
    ATT_WIDTH + 2 * ATT_KV_WIDTH + 2 * RET_QK_WIDTH + RET_WIDTH,
)
D_FF = 11008
FFN_HALF = 0.5
NORM_EPS = 1e-6
MASK_VALUE = -1e30

kernel_name = "hybrid_swa_retention_macaron_layer"


def rmsnorm(x, gain):
    xf = x.astype(jnp.float32)
    y = xf * lax.rsqrt(jnp.mean(xf * xf, axis=-1, keepdims=True) + NORM_EPS)
    return (y * gain.astype(jnp.float32)).astype(x.dtype)


def swiglu_ffn(x, w_gate_up, w_down):
    gate, up = jnp.split(x @ w_gate_up, 2, axis=-1)
    return (jax.nn.silu(gate) * up) @ w_down


def alibi_slopes():
    s = 2.0 ** (-8.0 * np.arange(1, ATT_HEADS + 1) / ATT_HEADS)
    return jnp.asarray(s, dtype=jnp.float32).reshape(ATT_KV_HEADS, ATT_GROUP)


def sliding_window_gqa(q, k, v, sinks, n_pad):
    B, Lp, _ = q.shape
    nb = Lp // BLOCK
    qb = q.reshape(B, nb, BLOCK, ATT_KV_HEADS, ATT_GROUP, ATT_HEAD_DIM)
    kb = k.reshape(B, nb, BLOCK, ATT_KV_HEADS, ATT_HEAD_DIM)
    vb = v.reshape(B, nb, BLOCK, ATT_KV_HEADS, ATT_HEAD_DIM)
    shift = ((0, 0), (1, 0), (0, 0), (0, 0), (0, 0))
    kk = jnp.concatenate([jnp.pad(kb[:, :-1], shift), kb], axis=2)
    vv = jnp.concatenate([jnp.pad(vb[:, :-1], shift), vb], axis=2)

    dist = BLOCK + jnp.arange(BLOCK)[:, None] - jnp.arange(2 * BLOCK)[None, :]
    band = (dist >= 0) & (dist < WINDOW)
    k_abs = (jnp.arange(nb)[:, None] - 1) * BLOCK + jnp.arange(2 * BLOCK)[None, :]
    valid = band[None] & (k_abs >= n_pad)[:, None, :]
    alibi = -alibi_slopes()[:, :, None, None] * dist.astype(jnp.float32)

    scores = jnp.einsum('bnqhgd,bnkhd->bnhgqk', qb, kk).astype(jnp.float32) * (ATT_HEAD_DIM ** -0.5)
    scores = jnp.where(valid[:, None, None], scores + alibi, MASK_VALUE)

    sink = sinks.astype(jnp.float32).reshape(ATT_KV_HEADS, ATT_GROUP)[None, None, :, :, None]
    m = jnp.maximum(scores.max(axis=-1), sink)
    p = jnp.exp(scores - m[..., None])
    denom = p.sum(axis=-1) + jnp.exp(sink - m)
    out = jnp.einsum('bnhgqk,bnkhd->bnqhgd', p.astype(v.dtype), vv)
    out = out / denom.transpose(0, 1, 4, 2, 3)[..., None].astype(out.dtype)
    return out.reshape(B, Lp, ATT_WIDTH)


def chunkwise_retention(q, k, v):
    B, Lp, H, dk = q.shape
    dv = v.shape[-1]
    nb = Lp // BLOCK
    log_gamma = jnp.log(1.0 - 2.0 ** (-5.0 - jnp.arange(H, dtype=jnp.float32)))
    pos = jnp.arange(BLOCK, dtype=jnp.float32)
    qc = q.reshape(B, nb, BLOCK, H, dk)
    kc = k.reshape(B, nb, BLOCK, H, dk) * (dk ** -0.5)
    vc = v.reshape(B, nb, BLOCK, H, dv)

    rel = pos[:, None] - pos[None, :]
    decay = jnp.where(rel >= 0, jnp.exp(jnp.maximum(rel, 0.0)[None] * log_gamma[:, None, None]), 0.0)
    s = jnp.einsum('bnihd,bnjhd->bnhij', qc, kc) * decay.astype(q.dtype)
    inner = jnp.einsum('bnhij,bnjhe->bnihe', s, vc)

    k_w = jnp.exp((BLOCK - 1 - pos)[:, None] * log_gamma[None, :]).astype(k.dtype)
    kv = jnp.einsum('bnjhd,bnjhe->nbhde', kc * k_w[:, :, None], vc)
    chunk_decay = jnp.exp(BLOCK * log_gamma).astype(kv.dtype)[:, None, None]

    def step(state, kv_n):
        return state * chunk_decay + kv_n, state

    _, prev_states = lax.scan(step, jnp.zeros((B, H, dk, dv), kv.dtype), kv)
    q_w = jnp.exp((pos + 1.0)[:, None] * log_gamma[None, :]).astype(q.dtype)
    cross = jnp.einsum('bnihd,nbhde->bnihe', qc * q_w[:, :, None], prev_states)
    return (inner + cross).reshape(B, Lp, H, dv)


def hybrid_mixer(h, w_in, b_in, attn_sinks, w_out):
    B, L, _ = h.shape
    n_pad = BLOCK - N_META
    proj = jnp.pad(h @ w_in + b_in, ((0, 0), (n_pad, 0), (0, 0)))
    Lp = proj.shape[1]
    q_a, k_a, v_a, q_r, k_r, v_r, g_r = jnp.split(proj, SPLIT_OFFSETS, axis=-1)

    attn = sliding_window_gqa(q_a, k_a, v_a, attn_sinks, n_pad)

    ret = chunkwise_retention(q_r.reshape(B, Lp, RET_HEADS, RET_QK_DIM),
                              k_r.reshape(B, Lp, RET_HEADS, RET_QK_DIM),
                              v_r.reshape(B, Lp, RET_HEADS, RET_V_DIM))
    rf = ret.astype(jnp.float32)
    rf = rf * lax.rsqrt(jnp.mean(rf * rf, axis=-1, keepdims=True) + NORM_EPS)
    ret = rf.astype(h.dtype).reshape(B, Lp, RET_WIDTH) * jax.nn.silu(g_r)

    merged = jnp.concatenate([attn, ret], axis=-1)[:, n_pad:]
    return merged @ w_out


def setup_inputs(seed: int = 0) -> dict:
    key = jax.random.key(seed)
    ks = jax.random.split(key, 16)
    f32 = jnp.float32

    def normal(k, shape, scale):
        return jax.random.normal(k, shape, f32) * scale

    def gain(k):
        return 1.0 + normal(k, (DEPTH, D_MODEL), 0.02)

    return {
        "x": normal(ks[0], (BATCH, SEQ, D_MODEL), 1.0),
        "meta_tokens": normal(ks[1], (N_META, D_MODEL), 1.0),
        "norm_ffn1": gain(ks[2]),
        "w_ffn1_gate_up": normal(ks[3], (DEPTH, D_MODEL, 2 * D_FF), D_MODEL ** -0.5),
        "w_ffn1_down": normal(ks[4], (DEPTH, D_FF, D_MODEL), D_FF ** -0.5),
        "norm_mix": gain(ks[5]),
        "w_in": normal(ks[6], (DEPTH, D_MODEL, IN_WIDTH), D_MODEL ** -0.5),
        "b_in": normal(ks[7], (DEPTH, IN_WIDTH), 0.02),
        "attn_sinks": normal(ks[8], (DEPTH, ATT_HEADS), 0.5),
        "w_out": normal(ks[9], (DEPTH, MIX_WIDTH, D_MODEL), MIX_WIDTH ** -0.5),
        "norm_ffn2": gain(ks[10]),
        "w_ffn2_gate_up": normal(ks[11], (DEPTH, D_MODEL, 2 * D_FF), D_MODEL ** -0.5),
        "w_ffn2_down": normal(ks[12], (DEPTH, D_FF, D_MODEL), D_FF ** -0.5),
        "norm_final": 1.0 + normal(ks[13], (D_MODEL,), 0.02),
    }


def reference(x, meta_tokens, norm_ffn1, w_ffn1_gate_up, w_ffn1_down, norm_mix, w_in, b_in,
              attn_sinks, w_out, norm_ffn2, w_ffn2_gate_up, w_ffn2_down, norm_final):
    B = x.shape[0]
    meta = jnp.broadcast_to(meta_tokens[None].astype(x.dtype), (B, N_META, D_MODEL))
    h = jnp.concatenate([meta, x], axis=1)
    for layer in range(DEPTH):
        h = h + FFN_HALF * swiglu_ffn(rmsnorm(h, norm_ffn1[layer]), w_ffn1_gate_up[layer], w_ffn1_down[layer])
        h = h + hybrid_mixer(rmsnorm(h, norm_mix[layer]), w_in[layer], b_in[layer], attn_sinks[layer], w_out[layer])
        h = h + FFN_HALF * swiglu_ffn(rmsnorm(h, norm_ffn2[layer]), w_ffn2_gate_up[layer], w_ffn2_down[layer])
    h = rmsnorm(h, norm_final)
    return h[:, N_META:]
```

```cpp
#include <hip/hip_runtime.h>
#include <cstdio>
#include <cstdint>
#define MK_PER_PHASE 0
namespace pg8 {
#define PG8_LAS __attribute__((address_space(3)))
typedef unsigned short bf16_t;
typedef short bf16x8 __attribute__((ext_vector_type(8)));
typedef float f32x4 __attribute__((ext_vector_type(4)));
typedef unsigned u32x4 __attribute__((ext_vector_type(4)));
typedef int i32x4 __attribute__((ext_vector_type(4)));
template <bool I8> struct AccSel { typedef f32x4 type; }; template <> struct AccSel<true> { typedef i32x4 type; };
constexpr int BM = 256, BK = 64, HALF = 128, HTB = HALF * BK * 2  , STAGE_BYTES = 8 * HTB, NXCD = 8, WGM = 8;

__host__ __device__ __forceinline__ int lds_byte(int r, int c) { const int st = (r >> 4) * 2 + (c >> 5), rr = r & 15, cc = c & 31, ob = rr * 64 + cc * 2; return st * 1024 + (ob ^ (((ob >> 9) & 1) << 5)); }
__host__ __device__ __forceinline__ void stage_rc(int b, int& R, int& C) { const int st = b / 1024, sb = b % 1024, swz = sb ^ (((sb >> 9) & 1) << 5); R = (st >> 1) * 16 + swz / 64; C = (st & 1) * 32 + (swz % 64) / 2; }
__host__ __device__ __forceinline__ int perm32(int rho) { const int n = rho >> 4, i = rho & 15; return 8 * (i >> 2) + 4 * n + (i & 3); }

struct Unit { int pm, pn, kt0, nkt, split, sl, r0; };
struct Gemm { const bf16_t* A; const bf16_t* Bt; int M, N, K; };

struct StaticOrder {
    int nM, nN, nwg, G, c, skip, grp;
    __host__ __device__ void init(int M, int N, int G_, int c_, int skip_ = 0, int grp_ = 1) { nM = M / BM; nN = N / BM; nwg = nM * nN; G = G_; c = c_; skip = skip_; grp = grp_; }
    __host__ __device__ bool next(int i, Unit& u) const {
        const long L = (long)i * G + c; if (L >= nwg) return false;
        int wgid = (int)L; { const int q = nwg / NXCD, r = nwg % NXCD, xcd = wgid % NXCD, off = wgid / NXCD; wgid = (xcd < r ? xcd * (q + 1) : r * (q + 1) + (xcd - r) * q) + off; }
        const int nig = WGM * nN, gid = wgid / nig, fm = gid * WGM, gsz = (nM - fm) < WGM ? (nM - fm) : WGM;
        u.pm = fm + ((wgid % nig) % gsz); u.pn = (wgid % nig) / gsz; u.r0 = u.pm * BM + (skip ? skip * (1 + u.pm / grp) : 0); return true;
    }
    __device__ __forceinline__ void a_ready(const Unit&) const {}
    __device__ __forceinline__ void done(const Unit&) const {}
};
struct SplitOrder {
    StaticOrder base; int G, c, nN, SL, ntp, pm_last;
    __host__ __device__ void init(int M, int N, int ntiles, int G_, int c_, int SL_) { base.init(M - BM, N, G_, c_); G = G_; c = c_; nN = N / BM; SL = SL_; ntp = ntiles / 2; pm_last = M / BM - 1; }
    __host__ __device__ bool next(int i, Unit& u) const {
        if (base.next(i, u)) return true;
        const long L = (long)i * G + c - base.nwg; if (L < 0 || L >= (long)nN * SL) return false;
        const int s = (int)(L / nN); u.pm = pm_last; u.pn = (int)(L % nN); u.r0 = pm_last * BM;
        const int p0 = (ntp * s) / SL, p1 = (ntp * (s + 1)) / SL; u.kt0 = 2 * p0; u.nkt = 2 * (p1 - p0); u.split = 1; u.sl = s; return u.nkt > 0;
    }
    __device__ __forceinline__ void a_ready(const Unit&) const {}
    __device__ __forceinline__ void done(const Unit&) const {}
};
__device__ __forceinline__ unsigned cvt_pk_bf16(float lo, float hi) { unsigned r; asm volatile("v_cvt_pk_bf16_f32 %0, %1, %2" : "=v"(r) : "v"(lo), "v"(hi)); return r; }
__device__ __forceinline__ float silu_f(float g) { return g * __builtin_amdgcn_rcpf(1.0f + __builtin_amdgcn_exp2f(-1.4426950408889634f * g)); }
template <bool HAS_RS> struct EpiSwiGLU {
    static constexpr bool PERM = true, AFTER_DRAIN = false;
    bf16_t* O; int ldc; const float* rstd;
    __device__ __forceinline__ void operator()(const f32x4 (&acc)[2][2][4][2], const Unit& u, int wr, int wc, int fr, int fq) const {
        const int row0 = u.r0 + wr * 64 + fr, col0 = u.pn * HALF + wc * 32 + 8 * fq;
        float rsv[2][4];
#pragma unroll
        for (int ai = 0; ai < 2; ++ai)
#pragma unroll
            for (int m = 0; m < 4; ++m) rsv[ai][m] = HAS_RS ? rstd[row0 + ai * HALF + m * 16] : 1.0f;
#pragma unroll
        for (int ai = 0; ai < 2; ++ai)
#pragma unroll
            for (int m = 0; m < 4; ++m) { bf16_t* rowp = O + (size_t)(row0 + ai * HALF + m * 16) * ldc + col0; const float rs = rsv[ai][m];
                const f32x4 g0 = acc[ai][0][m][0] * rs, g1 = acc[ai][0][m][1] * rs, u0 = acc[ai][1][m][0] * rs, u1 = acc[ai][1][m][1] * rs;
                float a[8];
#pragma unroll
                for (int j = 0; j < 4; ++j) { a[j] = silu_f(g0[j]) * u0[j]; a[4 + j] = silu_f(g1[j]) * u1[j]; }
                u32x4 w; w.x = cvt_pk_bf16(a[0], a[1]); w.y = cvt_pk_bf16(a[2], a[3]); w.z = cvt_pk_bf16(a[4], a[5]); w.w = cvt_pk_bf16(a[6], a[7]);
                *(u32x4*)rowp = w; }
    }
};
struct EpiSwiGLU8 {
    static constexpr bool PERM = true, AFTER_DRAIN = false;
    bf16_t* O; int ldc; const float* rowfac; const float* colmax;
    __device__ __forceinline__ void operator()(const i32x4 (&acc)[2][2][4][2], const Unit& u, int wr, int wc, int fr, int fq) const {
        const int row0 = u.r0 + wr * 64 + fr, col0 = u.pn * HALF + wc * 32 + 8 * fq, brow0 = u.pn * BM + wc * 32 + 8 * fq;
        float rsv[2][4]; f32x4 cg[2], cu[2];
#pragma unroll
        for (int ai = 0; ai < 2; ++ai)
#pragma unroll
            for (int m = 0; m < 4; ++m) rsv[ai][m] = rowfac[row0 + ai * HALF + m * 16];
#pragma unroll
        for (int n = 0; n < 2; ++n) { cg[n] = *(const f32x4*)(colmax + brow0 + 4 * n) * (1.0f / 127.0f); cu[n] = *(const f32x4*)(colmax + brow0 + HALF + 4 * n) * (1.0f / 127.0f); }
#pragma unroll
        for (int ai = 0; ai < 2; ++ai)
#pragma unroll
            for (int m = 0; m < 4; ++m) { bf16_t* rowp = O + (size_t)(row0 + ai * HALF + m * 16) * ldc + col0; const float rs = rsv[ai][m];
                const f32x4 g0 = __builtin_convertvector(acc[ai][0][m][0], f32x4) * cg[0] * rs, g1 = __builtin_convertvector(acc[ai][0][m][1], f32x4) * cg[1] * rs;
                const f32x4 u0 = __builtin_convertvector(acc[ai][1][m][0], f32x4) * cu[0] * rs, u1 = __builtin_convertvector(acc[ai][1][m][1], f32x4) * cu[1] * rs;
                float a[8];
#pragma unroll
                for (int j = 0; j < 4; ++j) { a[j] = silu_f(g0[j]) * u0[j]; a[4 + j] = silu_f(g1[j]) * u1[j]; }
                u32x4 w; w.x = cvt_pk_bf16(a[0], a[1]); w.y = cvt_pk_bf16(a[2], a[3]); w.z = cvt_pk_bf16(a[4], a[5]); w.w = cvt_pk_bf16(a[6], a[7]);
                *(u32x4*)rowp = w; }
    }
};
template <bool SRC_X> struct EpiResid {
    static constexpr bool PERM = true, AFTER_DRAIN = false;
    bf16_t* out; int ldc; float scale; float* part; const float* x0; const float* meta0; const bf16_t* src; int lp, npad, seq;
    __device__ __forceinline__ void operator()(const f32x4 (&acc)[2][2][4][2], const Unit& u, int wr, int wc, int fr, int fq) const {
        if (u.split) { store_partial(acc, u, wr, wc, fr, fq); return; }
        const int row0 = u.r0 + wr * 64 + fr, col0 = u.pn * BM + wc * 32 + 8 * fq;
#pragma unroll
        for (int ai = 0; ai < 2; ++ai)
#pragma unroll
            for (int m = 0; m < 4; ++m) { const int row = row0 + ai * HALF + m * 16; const size_t off = (size_t)row * ldc + col0;
                f32x4 h[2][2];
                if constexpr (SRC_X) { const float* srcp = x0; bool zero = false;
                    { const int b = row / lp, p = row - b * lp; if (p < npad) zero = true; else if (p < npad + 16) srcp = meta0 + (size_t)(p - npad) * ldc + col0; else srcp = x0 + ((size_t)b * seq + (size_t)(p - npad - 16)) * ldc + col0; }
#pragma unroll
                    for (int bj = 0; bj < 2; ++bj)
#pragma unroll
                        for (int n = 0; n < 2; ++n) h[bj][n] = zero ? (f32x4){0.f, 0.f, 0.f, 0.f} : *(const f32x4*)(srcp + bj * HALF + 4 * n);
                } else {
#pragma unroll
                    for (int bj = 0; bj < 2; ++bj) { const u32x4 w = *(const u32x4*)(src + off + bj * HALF);
                        h[bj][0] = (f32x4){__uint_as_float(w.x << 16), __uint_as_float(w.x & 0xffff0000u), __uint_as_float(w.y << 16), __uint_as_float(w.y & 0xffff0000u)};
                        h[bj][1] = (f32x4){__uint_as_float(w.z << 16), __uint_as_float(w.z & 0xffff0000u), __uint_as_float(w.w << 16), __uint_as_float(w.w & 0xffff0000u)}; }
                }
#pragma unroll
                for (int bj = 0; bj < 2; ++bj) { const f32x4 a0 = h[bj][0] + acc[ai][bj][m][0] * scale, a1 = h[bj][1] + acc[ai][bj][m][1] * scale;
                    u32x4 w; w.x = cvt_pk_bf16(a0[0], a0[1]); w.y = cvt_pk_bf16(a0[2], a0[3]); w.z = cvt_pk_bf16(a1[0], a1[1]); w.w = cvt_pk_bf16(a1[2], a1[3]);
                    *(u32x4*)(out + off + bj * HALF) = w; }
                asm volatile("" ::: "memory"); }
    }
    __device__ __forceinline__ void store_partial(const f32x4 (&acc)[2][2][4][2], const Unit& u, int wr, int wc, int fr, int fq) const {
        const int row0 = wr * 64 + fr, col0 = u.pn * BM + wc * 32 + 8 * fq; float* base = part + (size_t)u.sl * BM * ldc;
#pragma unroll
        for (int ai = 0; ai < 2; ++ai)
#pragma unroll
            for (int m = 0; m < 4; ++m) { float* rowp = base + (size_t)(row0 + ai * HALF + m * 16) * ldc + col0;
#pragma unroll
                for (int bj = 0; bj < 2; ++bj)
#pragma unroll
                    for (int n = 0; n < 2; ++n) *(f32x4*)(rowp + bj * HALF + 4 * n) = acc[ai][bj][m][n] * scale; }
    }
};
template <bool SRC_X> struct EpiResid8 {
    static constexpr bool PERM = true, AFTER_DRAIN = false;
    bf16_t* out; int ldc; float scale; float* part; const float* x0; const float* meta0; const bf16_t* src; int lp, npad, seq; const unsigned* rowmax; const float* colmax;
    float* sq; int sqld;
    __device__ __forceinline__ void operator()(const i32x4 (&acc)[2][2][4][2], const Unit& u, int wr, int wc, int fr, int fq) const {
        const int row0 = u.r0 + wr * 64 + fr, col0 = u.pn * BM + wc * 32 + 8 * fq;
        f32x4 cf[2][2]; float rf[2][4];
#pragma unroll
        for (int bj = 0; bj < 2; ++bj)
#pragma unroll
            for (int n = 0; n < 2; ++n) cf[bj][n] = *(const f32x4*)(colmax + col0 + bj * HALF + 4 * n) * (scale * (1.0f / (127.0f * 127.0f)));
#pragma unroll
        for (int ai = 0; ai < 2; ++ai)
#pragma unroll
            for (int m = 0; m < 4; ++m) rf[ai][m] = __uint_as_float(rowmax[row0 + ai * HALF + m * 16]);
        if (u.split) {
            const int prow0 = wr * 64 + fr; float* base = part + (size_t)u.sl * BM * ldc;
#pragma unroll
            for (int ai = 0; ai < 2; ++ai)
#pragma unroll
                for (int m = 0; m < 4; ++m) { float* rowp = base + (size_t)(prow0 + ai * HALF + m * 16) * ldc + col0;
#pragma unroll
                    for (int bj = 0; bj < 2; ++bj)
#pragma unroll
                        for (int n = 0; n < 2; ++n) *(f32x4*)(rowp + bj * HALF + 4 * n) = __builtin_convertvector(acc[ai][bj][m][n], f32x4) * cf[bj][n] * rf[ai][m]; }
            return; }
#pragma unroll
        for (int ai = 0; ai < 2; ++ai)
#pragma unroll
            for (int m = 0; m < 4; ++m) { const int row = row0 + ai * HALF + m * 16; const size_t off = (size_t)row * ldc + col0;
                f32x4 h[2][2];
                if constexpr (SRC_X) { const float* srcp = x0; bool zero = false;
                    { const int b = row / lp, p = row - b * lp; if (p < npad) zero = true; else if (p < npad + 16) srcp = meta0 + (size_t)(p - npad) * ldc + col0; else srcp = x0 + ((size_t)b * seq + (size_t)(p - npad - 16)) * ldc + col0; }
#pragma unroll
                    for (int bj = 0; bj < 2; ++bj)
#pragma unroll
                        for (int n = 0; n < 2; ++n) h[bj][n] = zero ? (f32x4){0.f, 0.f, 0.f, 0.f} : *(const f32x4*)(srcp + bj * HALF + 4 * n);
                } else {
#pragma unroll
                    for (int bj = 0; bj < 2; ++bj) { const u32x4 w = *(const u32x4*)(src + off + bj * HALF);
                        h[bj][0] = (f32x4){__uint_as_float(w.x << 16), __uint_as_float(w.x & 0xffff0000u), __uint_as_float(w.y << 16), __uint_as_float(w.y & 0xffff0000u)};
                        h[bj][1] = (f32x4){__uint_as_float(w.z << 16), __uint_as_float(w.z & 0xffff0000u), __uint_as_float(w.w << 16), __uint_as_float(w.w & 0xffff0000u)}; }
                }
                float ss = 0.f;
#pragma unroll
                for (int bj = 0; bj < 2; ++bj) { const f32x4 a0 = h[bj][0] + __builtin_convertvector(acc[ai][bj][m][0], f32x4) * cf[bj][0] * rf[ai][m], a1 = h[bj][1] + __builtin_convertvector(acc[ai][bj][m][1], f32x4) * cf[bj][1] * rf[ai][m];
                    u32x4 w; w.x = cvt_pk_bf16(a0[0], a0[1]); w.y = cvt_pk_bf16(a0[2], a0[3]); w.z = cvt_pk_bf16(a1[0], a1[1]); w.w = cvt_pk_bf16(a1[2], a1[3]);
                    *(u32x4*)(out + off + bj * HALF) = w;
                    if (sq) ss += ((a0[0] * a0[0] + a0[1] * a0[1]) + (a0[2] * a0[2] + a0[3] * a0[3])) + ((a1[0] * a1[0] + a1[1] * a1[1]) + (a1[2] * a1[2] + a1[3] * a1[3])); }
                if (sq) { ss += __shfl_xor(ss, 16); ss += __shfl_xor(ss, 32); if (fq == 0) sq[(size_t)(4 * u.pn + wc) * sqld + row] = ss; }
                asm volatile("" ::: "memory"); }
    }
};
struct EpiProj {
    static constexpr bool PERM = true, AFTER_DRAIN = false;
    bf16_t* O; int ldc; const float* bias; int lp, npad; const float* rstd;
    __device__ __forceinline__ void operator()(const f32x4 (&acc)[2][2][4][2], const Unit& u, int wr, int wc, int fr, int fq) const {
        const int row0 = u.r0 + wr * 64 + fr, col0 = u.pn * BM + wc * 32 + 8 * fq;
        f32x4 bv[2][2];
#pragma unroll
        for (int bj = 0; bj < 2; ++bj)
#pragma unroll
            for (int n = 0; n < 2; ++n) bv[bj][n] = *(const f32x4*)(bias + col0 + bj * HALF + 4 * n);
        float rsv[2][4];
#pragma unroll
        for (int ai = 0; ai < 2; ++ai)
#pragma unroll
            for (int m = 0; m < 4; ++m) rsv[ai][m] = rstd[row0 + ai * HALF + m * 16];
#pragma unroll
        for (int ai = 0; ai < 2; ++ai)
#pragma unroll
            for (int m = 0; m < 4; ++m) { const int row = row0 + ai * HALF + m * 16; bf16_t* rowp = O + (size_t)row * ldc + col0;
                const bool pad = (row % lp) < npad; const float rs = rsv[ai][m];
#pragma unroll
                for (int bj = 0; bj < 2; ++bj) { const f32x4 v0 = acc[ai][bj][m][0] * rs + bv[bj][0], v1 = acc[ai][bj][m][1] * rs + bv[bj][1];
                    u32x4 w; w.x = cvt_pk_bf16(v0[0], v0[1]); w.y = cvt_pk_bf16(v0[2], v0[3]); w.z = cvt_pk_bf16(v1[0], v1[1]); w.w = cvt_pk_bf16(v1[2], v1[3]);
                    if (pad) w = (u32x4){0u, 0u, 0u, 0u};
                    *(u32x4*)(rowp + bj * HALF) = w; } }
    }
};
template <bool I8> __device__ __forceinline__ typename AccSel<I8>::type mma16(bf16x8 a, bf16x8 b, typename AccSel<I8>::type c) {
    if constexpr (I8) return __builtin_amdgcn_mfma_i32_16x16x64_i8(__builtin_bit_cast(i32x4, a), __builtin_bit_cast(i32x4, b), c, 0, 0, 0);
    else return __builtin_amdgcn_mfma_f32_16x16x32_bf16(a, b, c, 0, 0, 0);
}
template <class Epi, class Sched, bool ALIGN_EPI = false, bool SP2 = false, bool I8 = false>
__device__ __forceinline__ void gemm_phase(PG8_LAS unsigned char* lds, const Gemm g, const Sched& S, const Epi& E) {
    const int tid = threadIdx.x, wid = __builtin_amdgcn_readfirstlane(tid >> 6), lane = tid & 63, wr = wid >> 2, wc = wid & 3, fr = lane & 15, fq = lane >> 4;
    const int K = g.K, RB = I8 ? K : 2 * K  , nt = RB / (2 * BK);
    unsigned voffA[2], voffB[2];
#pragma unroll
    for (int i = 0; i < 2; ++i) { int R, C; stage_rc(tid * 16 + i * 8192, R, C); const int Rb = Epi::PERM ? ((R & ~31) + perm32(R & 31)) : R;
        voffA[i] = (unsigned)(R * RB + 2 * C); voffB[i] = (unsigned)(Rb * RB + 2 * C); }
    const size_t kstep = (size_t)(BK * 2);
    const size_t hstep = (size_t)HALF * RB;
    const size_t tstep = 2 * hstep;
    const unsigned ldsw = (unsigned)wid * 1024u;
    const int aoff = lds_byte(wr * 64 + fr, fq * 8), boff = lds_byte(wc * 32 + fr, fq * 8);
#define PG8_SA(b, h) (((b) * 2 + (h)) * HTB)
#define PG8_SB(b, h) ((4 + (b) * 2 + (h)) * HTB)
#define PG8_STAGE(bufoff, gbase, voff) do { _Pragma("unroll") for (int _i = 0; _i < 2; ++_i) \
        __builtin_amdgcn_global_load_lds((const unsigned*)((const char*)(gbase) + (voff)[_i]), (PG8_LAS unsigned*)(lds + (bufoff) + ldsw + _i * 8192), 16, 0, 0); } while (0)
#define PG8_LDA(dst, b, h) do { _Pragma("unroll") for (int m = 0; m < 4; ++m) _Pragma("unroll") for (int k = 0; k < 2; ++k) dst[m][k] = *(const PG8_LAS bf16x8*)(lds + PG8_SA(b, h) + aoff + m * 2048 + k * 1024); } while (0)
#define PG8_LDB(dst, b, h) do { _Pragma("unroll") for (int n = 0; n < 2; ++n) _Pragma("unroll") for (int k = 0; k < 2; ++k) dst[n][k] = *(const PG8_LAS bf16x8*)(lds + PG8_SB(b, h) + boff + n * 2048 + k * 1024); } while (0)
#define PG8_MMA(ai, bj, At, Bt) do { __builtin_amdgcn_s_setprio(1); asm volatile(".p2align 3"); _Pragma("unroll") for (int m = 0; m < 2; ++m) _Pragma("unroll") for (int n = 0; n < 2; ++n) _Pragma("unroll") for (int k = 0; k < 2; ++k) \
        acc[ai][bj][m][n] = mma16<I8>(Bt[n][k], At[m][k], acc[ai][bj][m][n]); __builtin_amdgcn_s_setprio(0); __builtin_amdgcn_s_setprio(1); asm volatile(".p2align 3"); _Pragma("unroll") for (int m = 2; m < 4; ++m) _Pragma("unroll") for (int n = 0; n < 2; ++n) _Pragma("unroll") for (int k = 0; k < 2; ++k) \
        acc[ai][bj][m][n] = mma16<I8>(Bt[n][k], At[m][k], acc[ai][bj][m][n]); __builtin_amdgcn_s_setprio(0); } while (0)
#define PG8_WAIT_V(n) asm volatile("s_waitcnt vmcnt(" #n ")" ::: "memory")
#define PG8_WAIT_L(n) asm volatile("s_waitcnt lgkmcnt(" #n ")" ::: "memory")
#define PG8_BAR __builtin_amdgcn_s_barrier()
#define PG8_SCHED __builtin_amdgcn_sched_barrier(0)
    Unit cur, nxt; int ui = 0;
    cur.kt0 = 0; cur.nkt = nt; cur.split = 0; cur.sl = 0;
    if (!S.next(0, cur)) return;
    typedef typename AccSel<I8>::type acc_t; const acc_t acc_zero = {};
    acc_t acc[2][2][4][2];
#pragma unroll
    for (int a = 0; a < 2; ++a)
#pragma unroll
        for (int b = 0; b < 2; ++b)
#pragma unroll
            for (int m = 0; m < 4; ++m)
#pragma unroll
                for (int n = 0; n < 2; ++n) acc[a][b][m][n] = acc_zero;
    bf16x8 At[4][2], B0[2][2], B1[2][2];
    const char* cA = (const char*)g.A + (size_t)cur.r0 * RB + (size_t)cur.kt0 * kstep; const char* cB = (const char*)g.Bt + (size_t)cur.pn * tstep + (size_t)cur.kt0 * kstep;
    S.a_ready(cur);
    if constexpr (SP2) {
        PG8_STAGE(PG8_SB(0, 0), cB, voffB); PG8_STAGE(PG8_SB(0, 1), cB + hstep, voffB); PG8_STAGE(PG8_SA(0, 0), cA, voffA); PG8_STAGE(PG8_SA(0, 1), cA + hstep, voffA);
        if (wr == 1) PG8_BAR;
        PG8_WAIT_V(2); PG8_BAR;
        PG8_STAGE(PG8_SB(1, 0), cB + kstep, voffB); PG8_STAGE(PG8_SA(1, 0), cA + kstep, voffA); PG8_STAGE(PG8_SB(1, 1), cB + hstep + kstep, voffB);
        PG8_WAIT_V(6); PG8_BAR;
    } else {
        PG8_STAGE(PG8_SB(0, 0), cB, voffB); PG8_STAGE(PG8_SA(0, 0), cA, voffA); PG8_STAGE(PG8_SB(0, 1), cB + hstep, voffB); PG8_STAGE(PG8_SA(0, 1), cA + hstep, voffA);
        if (wr == 1) PG8_BAR;
        PG8_WAIT_V(4); PG8_BAR;
        PG8_STAGE(PG8_SB(1, 0), cB + kstep, voffB); PG8_STAGE(PG8_SA(1, 0), cA + kstep, voffA); PG8_STAGE(PG8_SB(1, 1), cB + hstep + kstep, voffB);
        PG8_WAIT_V(6); PG8_BAR;
    }
    for (;;) {
        nxt.kt0 = 0; nxt.nkt = nt; nxt.split = 0; nxt.sl = 0;
        const bool has_next = S.next(ui + 1, nxt);
        const int cnt = cur.nkt;
        const char* nA = has_next ? (const char*)g.A + (size_t)nxt.r0 * RB + (size_t)nxt.kt0 * kstep : cA; const char* nB = has_next ? (const char*)g.Bt + (size_t)nxt.pn * tstep + (size_t)nxt.kt0 * kstep : cB;
        for (int t = 0; t < cnt; t += 2) {
            const bool last = (t == cnt - 2);
            const char* a1 = cA + (size_t)(t + 1) * kstep;
            const char* a2 = last ? nA : cA + (size_t)(t + 2) * kstep; const char* b2 = last ? nB : cB + (size_t)(t + 2) * kstep;
            const char* a3 = a2 + kstep; const char* b3 = b2 + kstep;
            if (last && has_next) S.a_ready(nxt);
            if constexpr (SP2) {
            PG8_LDB(B0, 0, 0); PG8_LDB(B1, 0, 1); PG8_SCHED; PG8_LDA(At, 0, 0); PG8_STAGE(PG8_SA(1, 1), a1 + hstep, voffA);
            PG8_WAIT_V(8); PG8_WAIT_L(0); PG8_BAR; PG8_MMA(0, 0, At, B0); PG8_MMA(0, 1, At, B1); PG8_BAR; PG8_SCHED;
            PG8_LDA(At, 0, 1); PG8_STAGE(PG8_SB(0, 0), b2, voffB); PG8_STAGE(PG8_SB(0, 1), b2 + hstep, voffB); PG8_STAGE(PG8_SA(0, 0), a2, voffA);
            PG8_WAIT_V(8); PG8_WAIT_L(0); PG8_BAR; PG8_MMA(1, 0, At, B0); PG8_MMA(1, 1, At, B1); PG8_BAR; PG8_SCHED;
            PG8_LDB(B0, 1, 0); PG8_LDB(B1, 1, 1); PG8_SCHED; PG8_LDA(At, 1, 0); PG8_STAGE(PG8_SA(0, 1), a2 + hstep, voffA);
            PG8_WAIT_V(8); PG8_WAIT_L(0); PG8_BAR; PG8_MMA(0, 0, At, B0); PG8_MMA(0, 1, At, B1); PG8_BAR; PG8_SCHED;
            PG8_LDA(At, 1, 1); PG8_STAGE(PG8_SB(1, 0), b3, voffB); PG8_STAGE(PG8_SB(1, 1), b3 + hstep, voffB); PG8_STAGE(PG8_SA(1, 0), a3, voffA);
            PG8_WAIT_V(8); PG8_WAIT_L(0); PG8_BAR; PG8_MMA(1, 0, At, B0); PG8_MMA(1, 1, At, B1); PG8_BAR; PG8_SCHED;
            } else {
            PG8_LDB(B0, 0, 0); PG8_SCHED; PG8_LDA(At, 0, 0); PG8_STAGE(PG8_SA(1, 1), a1 + hstep, voffA);
            PG8_WAIT_L(8); PG8_BAR; PG8_WAIT_L(0); PG8_MMA(0, 0, At, B0); PG8_BAR; PG8_SCHED;
            PG8_LDB(B1, 0, 1); PG8_STAGE(PG8_SB(0, 0), b2, voffB);
            PG8_BAR; PG8_WAIT_L(0); PG8_MMA(0, 1, At, B1); PG8_BAR;
            PG8_LDA(At, 0, 1); PG8_STAGE(PG8_SA(0, 0), a2, voffA);
            PG8_BAR; PG8_WAIT_L(0); PG8_MMA(1, 0, At, B0); PG8_BAR; PG8_SCHED;
            PG8_STAGE(PG8_SB(0, 1), b2 + hstep, voffB);
            PG8_WAIT_V(6); PG8_BAR; PG8_MMA(1, 1, At, B1); PG8_BAR;
            PG8_LDB(B0, 1, 0); PG8_SCHED; PG8_LDA(At, 1, 0); PG8_STAGE(PG8_SA(0, 1), a2 + hstep, voffA);
            PG8_WAIT_L(8); PG8_BAR; PG8_WAIT_L(0); PG8_MMA(0, 0, At, B0); PG8_BAR; PG8_SCHED;
            PG8_LDB(B1, 1, 1); PG8_STAGE(PG8_SB(1, 0), b3, voffB);
            PG8_BAR; PG8_WAIT_L(0); PG8_MMA(0, 1, At, B1); PG8_BAR;
            PG8_LDA(At, 1, 1); PG8_STAGE(PG8_SA(1, 0), a3, voffA);
            PG8_BAR; PG8_WAIT_L(0); PG8_MMA(1, 0, At, B0); PG8_BAR; PG8_SCHED;
            PG8_STAGE(PG8_SB(1, 1), b3 + hstep, voffB);
            PG8_WAIT_V(6); PG8_BAR; PG8_MMA(1, 1, At, B1); PG8_BAR;
            }
        }
        if constexpr (ALIGN_EPI) { if (wr == 0) PG8_BAR; }
        if constexpr (!Epi::AFTER_DRAIN) { E(acc, cur, wr, wc, fr, fq); S.done(cur); }
        if (!has_next) break;
#pragma unroll
        for (int a = 0; a < 2; ++a)
#pragma unroll
            for (int b = 0; b < 2; ++b)
#pragma unroll
                for (int m = 0; m < 4; ++m)
#pragma unroll
                    for (int n = 0; n < 2; ++n) acc[a][b][m][n] = acc_zero;
        cur = nxt; cA = nA; cB = nB; ++ui;
        if constexpr (ALIGN_EPI) { if (wr == 1) PG8_BAR; }
    }
    PG8_WAIT_V(0);
    if constexpr (!ALIGN_EPI) { if (wr == 0) PG8_BAR; }
    PG8_BAR;
    if constexpr (Epi::AFTER_DRAIN) { E.fused(acc, cur, wr, wc, fr, fq, lds, wid, lane); S.done(cur); }
#undef PG8_SA
#undef PG8_SB
#undef PG8_STAGE
#undef PG8_LDA
#undef PG8_LDB
#undef PG8_MMA
#undef PG8_WAIT_V
#undef PG8_WAIT_L
#undef PG8_BAR
#undef PG8_SCHED
}
}
#ifndef MK_PER_PHASE
#define MK_PER_PHASE 0
#endif
constexpr int NWAVES = 8;
constexpr int D = 4096, SEQ = 8192, NB = 2, LP = 8320, NCH = 65, NPAD = 112, M = NB * LP;
constexpr int FF = 11008, NGU = 2 * FF, INW = 10752;
constexpr int OFF_QA = 0, OFF_KA = 2048, OFF_VA = 2304, OFF_QR = 2560, OFF_KR = 4608, OFF_VR = 6656, OFF_GR = 8704;
constexpr float EPS = 1e-6f, LOG2E = 1.4426950408889634f;
static_assert(M % 256 == 0 && NGU % 256 == 0 && INW % 256 == 0 && FF % 128 == 0, "GEMM tiling");

constexpr size_t MiB = 1u << 20;
constexpr size_t WS_CTL = 0, CTL_ZERO_BYTES = 1 * MiB;
constexpr size_t WS_H = 1 * MiB;
constexpr size_t WS_XN = 261 * MiB;
constexpr size_t WS_ACT = 563 * MiB;
constexpr size_t WS_WGU = 391 * MiB;
constexpr size_t WS_WD = 913 * MiB;
constexpr size_t WS_WIN = 999 * MiB;
constexpr size_t WS_WOUT = 1083 * MiB;
constexpr size_t WS_ST = 1115 * MiB;
constexpr size_t WS_HB2 = 1245 * MiB;
constexpr size_t WS_WD8 = 1375 * MiB;
constexpr size_t WS_END = 1418 * MiB;
constexpr size_t WS_RSTD = 512 * 1024;
constexpr size_t WS_ROWFAC = 580 * 1024;
constexpr size_t WS_ROWMAXD1 = 824 * 1024, WS_ROWMAXD2 = 890 * 1024, WS_COLMAXD1 = 956 * 1024, WS_COLMAXD2 = 972 * 1024;
constexpr size_t WS_COLMAX1 = 648 * 1024, WS_COLMAX2 = 736 * 1024;
constexpr int CW_BAR = 4096;
static_assert(WS_ROWFAC >= WS_RSTD + (size_t)M * 4 && WS_COLMAX1 >= WS_ROWFAC + (size_t)M * 4 && WS_COLMAX2 >= WS_COLMAX1 + (size_t)NGU * 4 && WS_COLMAX2 + (size_t)NGU * 4 <= CTL_ZERO_BYTES, "control region map");


constexpr int SCR_BYTES = 143360;
constexpr int MISC_OFF = SCR_BYTES;
constexpr int LDS_BYTES = 147456;

#define GAS __attribute__((address_space(1)))
#define LAS __attribute__((address_space(3)))
typedef unsigned short bf16;
typedef unsigned v4u __attribute__((ext_vector_type(4)));
typedef unsigned v2u __attribute__((ext_vector_type(2)));
typedef float f32x4 __attribute__((ext_vector_type(4)));
typedef short bf16x8 __attribute__((ext_vector_type(8)));
typedef short s16x4 __attribute__((ext_vector_type(4)));
#define LDS_WAIT() asm volatile("s_waitcnt lgkmcnt(0)" ::: "memory")
#define MFMA16(a, b, c) __builtin_amdgcn_mfma_f32_16x16x32_bf16((a), (b), (c), 0, 0, 0)
__device__ __forceinline__ float bf2f(unsigned b16) { return __uint_as_float(b16 << 16); }
typedef float f32x2_t __attribute__((ext_vector_type(2))); typedef __bf16 bf16x2_t __attribute__((ext_vector_type(2)));
__device__ __forceinline__ unsigned pk2(float lo, float hi) { const f32x2_t v = {lo, hi}; return __builtin_bit_cast(unsigned, __builtin_convertvector(v, bf16x2_t)); }
__device__ __forceinline__ float wave_sum(float v) {
#pragma unroll
    for (int o = 1; o < 64; o <<= 1) v += __shfl_xor(v, o);
    return v;
}
__device__ __forceinline__ s16x4 ds_tr16(const LAS unsigned char* p) { return __builtin_bit_cast(s16x4, __builtin_amdgcn_ds_read_tr16_b64_v4i16((LAS s16x4*)p)); }
__device__ __forceinline__ bf16x8 cat8(s16x4 lo, s16x4 hi) { return (bf16x8){lo[0], lo[1], lo[2], lo[3], hi[0], hi[1], hi[2], hi[3]}; }
__device__ __forceinline__ float log2_gamma(int h) { return log1pf(-exp2f(-5.0f - (float)h)) * LOG2E; }

#define XB_TMO      128
#define XB_XCNT(j)  (256  + 64 * (j))
#define XB_XSUB(j)  (1280 + 64 * (j))
#define XB_XGEN(j)  (2304 + 64 * (j))
#define XB_TOP      3328
#define XB_TOPGEN   3392
#define XCD_BAR_WORDS 3456
#define XB_SPIN_CAP (1u << 18)

__device__ __forceinline__ unsigned xb_ld(unsigned* p)              { return __hip_atomic_load(p, __ATOMIC_RELAXED, __HIP_MEMORY_SCOPE_AGENT); }
__device__ __forceinline__ unsigned xb_add(unsigned* p, unsigned v) { return __hip_atomic_fetch_add(p, v, __ATOMIC_RELAXED, __HIP_MEMORY_SCOPE_AGENT); }
__device__ __forceinline__ unsigned xb_xcc_id() { return (unsigned)__builtin_amdgcn_s_getreg((3 << 11) | 20) & 0xFu; }
#define XB_SPIN(cond, bar) do { unsigned _sp = 0; while (cond) { __builtin_amdgcn_s_sleep(1); \
    if ((++_sp & 255u) == 0u) { if (xb_ld(&(bar)[XB_TMO])) break; if (_sp > XB_SPIN_CAP) { atomicAdd(&(bar)[XB_TMO], 1u); break; } } } } while (0)

struct XcdBarrier {
    unsigned* bar; unsigned x;
    volatile LAS unsigned* st;
};

__device__ __forceinline__ XcdBarrier xcd_barrier_post(unsigned* bar, volatile LAS unsigned* st) {
    XcdBarrier b; b.bar = bar; b.x = xb_xcc_id(); b.st = st;
    if (threadIdx.x == 0) (void)xb_add(&bar[XB_XCNT(b.x)], 1u);
    return b;
}
__device__ __forceinline__ void xcd_barrier_complete(unsigned* bar, unsigned x, unsigned& nloc, unsigned& nx) {
    const unsigned G = gridDim.x * gridDim.y * gridDim.z;
    unsigned sum, cnt, mine, sp = 0u;
    for (;;) {
        sum = 0u; cnt = 0u; mine = 0u;
#pragma unroll
        for (unsigned j = 0; j < 16; ++j) { const unsigned c = xb_ld(&bar[XB_XCNT(j)]); sum += c; cnt += (c > 0u) ? 1u : 0u; mine = (j == x) ? c : mine; }
        if (sum == G) break;
        __builtin_amdgcn_s_sleep(1);
        if ((++sp & 255u) == 0u) { if (xb_ld(&bar[XB_TMO])) break; if (sp > XB_SPIN_CAP) { atomicAdd(&bar[XB_TMO], 1u); break; } }
    }
    nloc = mine > 0u ? mine : 1u; nx = cnt > 0u ? cnt : 1u;
}

__device__ __forceinline__ void xcd_barrier(const XcdBarrier& b) {
    asm volatile("s_waitcnt vmcnt(0)" ::: "memory");
    __syncthreads();
    if (threadIdx.x == 0) {
        unsigned* bar = b.bar;
        __builtin_amdgcn_s_waitcnt(0);
        unsigned nloc = b.st[0], nx = b.st[1];
        if (nloc == 0u) { xcd_barrier_complete(bar, b.x, nloc, nx); b.st[0] = nloc; b.st[1] = nx; }
        const unsigned old = xb_add(&bar[XB_XSUB(b.x)], 1u);
        const unsigned gen = old / nloc;
        if (old + 1u == (gen + 1u) * nloc) {
            __builtin_amdgcn_fence(__ATOMIC_RELEASE, "agent");
            asm volatile("s_waitcnt vmcnt(0)" ::: "memory");
            const unsigned og = xb_add(&bar[XB_TOP], 1u);
            const unsigned tg = og / nx;
            if (og + 1u == (tg + 1u) * nx) xb_add(&bar[XB_TOPGEN], 1u);
            else XB_SPIN(xb_ld(&bar[XB_TOPGEN]) == tg, bar);
            __builtin_amdgcn_fence(__ATOMIC_ACQUIRE, "agent");
            xb_add(&bar[XB_XGEN(b.x)], 1u);
            asm volatile("s_waitcnt vmcnt(0)" ::: "memory");
        } else {
            XB_SPIN(xb_ld(&bar[XB_XGEN(b.x)]) == gen, bar);
            __builtin_amdgcn_fence(__ATOMIC_ACQUIRE, "agent");
            asm volatile("s_waitcnt vmcnt(0)" ::: "memory");
        }
    }
    __syncthreads();
}


__device__ __forceinline__ void rows_init(const float* x, const float* meta, bf16* HB, float* rstd, int gw, int NGW, int lane) {
    for (int r = gw; r < M; r += NGW) {
        const int b = r / LP, p = r - b * LP;
        const bool zero = p < NPAD; const float* src = (p < 128) ? meta + (size_t)(zero ? 0 : p - NPAD) * D : x + ((size_t)b * SEQ + (size_t)(p - 128)) * D;
        f32x4 v[16]; float ss = 0.f;
#pragma unroll
        for (int j = 0; j < 16; ++j) { v[j] = zero ? (f32x4){0.f, 0.f, 0.f, 0.f} : ((const f32x4*)src)[lane + 64 * j]; ss += (v[j].x * v[j].x + v[j].y * v[j].y) + (v[j].z * v[j].z + v[j].w * v[j].w); }
        ss = wave_sum(ss);
        const float rs = 1.0f / sqrtf(ss * (1.0f / D) + EPS);
#pragma unroll
        for (int j = 0; j < 16; ++j) { const f32x4 y = v[j] * rs; v2u w; w.x = pk2(y.x, y.y); w.y = pk2(y.z, y.w); ((v2u*)(HB + (size_t)r * D))[lane + 64 * j] = w; }
    }
}
__device__ __forceinline__ f32x4 bf4_to_f32(v2u w) { return (f32x4){__uint_as_float(w.x << 16), __uint_as_float(w.x & 0xffff0000u), __uint_as_float(w.y << 16), __uint_as_float(w.y & 0xffff0000u)}; }
constexpr int NSL_D1 = 3;
constexpr float P2_TAIL_FRAC = 0.85f;
template <bool FROM_X, bool Q8 = false>
__device__ __forceinline__ void stats_phase(const float* x, const bf16* Hprev, bf16* HB, float* rstd, const float* part, LAS float* red, int bx, int G, int gw, int NGW, int wave, int lane, unsigned char* A8 = nullptr, const float* sq = nullptr) {
    if (part) for (int hr = bx; hr < 256; hr += G) {
        const int r = M - 256 + hr, b = r / LP, p = r - b * LP;
        f32x4 v[2]; float ss = 0.f, am = 0.f;
#pragma unroll
        for (int j = 0; j < 2; ++j) { const size_t c = (size_t)(512 * wave + 256 * j + 4 * lane);
            v[j] = FROM_X ? *(const f32x4*)(x + ((size_t)b * SEQ + (size_t)(p - 128)) * D + c) : bf4_to_f32(*(const v2u*)(Hprev + (size_t)r * D + c));
#pragma unroll
            for (int s = 0; s < NSL_D1; ++s) v[j] = v[j] + *(const f32x4*)(part + ((size_t)s * 256 + hr) * D + c);
            { v2u w; w.x = pk2(v[j].x, v[j].y); w.y = pk2(v[j].z, v[j].w); *(v2u*)(HB + (size_t)r * D + c) = w; }
            ss += (v[j].x * v[j].x + v[j].y * v[j].y) + (v[j].z * v[j].z + v[j].w * v[j].w);
            am = fmaxf(fmaxf(am, fmaxf(fabsf(v[j].x), fabsf(v[j].y))), fmaxf(fabsf(v[j].z), fabsf(v[j].w))); }
        ss = wave_sum(ss);
#pragma unroll
        for (int o = 1; o < 64; o <<= 1) am = fmaxf(am, __shfl_xor(am, o));
        if (lane == 0) { red[wave] = ss; red[NWAVES + wave] = am; }
        __syncthreads();
        float tot = 0.f, amt = 0.f;
#pragma unroll
        for (int w = 0; w < NWAVES; ++w) { tot += red[w]; amt = fmaxf(amt, red[NWAVES + w]); }
        __syncthreads();
        const float rs = 1.0f / sqrtf(tot * (1.0f / D) + EPS);
        if (!Q8) { if (wave == 0 && lane == 0) rstd[r] = rs; }
        else { const float inv = amt > 0.f ? 127.0f / amt : 0.f; if (wave == 0 && lane == 0) rstd[r] = rs * amt * (1.0f / 127.0f);
#pragma unroll
            for (int j = 0; j < 2; ++j) { const size_t c = (size_t)(512 * wave + 256 * j + 4 * lane);
                const int b0 = (int)rintf(v[j].x * inv), b1 = (int)rintf(v[j].y * inv), b2 = (int)rintf(v[j].z * inv), b3 = (int)rintf(v[j].w * inv);
                *(unsigned*)(A8 + (size_t)r * D + c) = (unsigned)(b0 & 0xff) | ((unsigned)(b1 & 0xff) << 8) | ((unsigned)(b2 & 0xff) << 16) | ((unsigned)(b3 & 0xff) << 24); } }
    }
    if (!Q8 && sq) {
        for (int r = gw * 64 + lane; r < M - 256; r += NGW * 64) { float s = 0.f;
#pragma unroll 16
            for (int t = 0; t < 64; ++t) s += sq[(size_t)t * M + r];
            rstd[r] = 1.0f / sqrtf(s * (1.0f / D) + EPS); }
        return; }
    for (int r = gw; r < (part ? M - 256 : M); r += NGW) {
        if (!part && (r % LP) < 128) continue;
        float ss = 0.f, am = 0.f; v4u wq[8];
#pragma unroll
        for (int j = 0; j < 8; ++j) { const v4u w = ((const v4u*)(HB + (size_t)r * D))[lane + 64 * j]; wq[j] = w;
            const float a0 = bf2f(w.x & 0xffffu), a1 = bf2f(w.x >> 16), a2 = bf2f(w.y & 0xffffu), a3 = bf2f(w.y >> 16), a4 = bf2f(w.z & 0xffffu), a5 = bf2f(w.z >> 16), a6 = bf2f(w.w & 0xffffu), a7 = bf2f(w.w >> 16);
            ss += ((a0 * a0 + a1 * a1) + (a2 * a2 + a3 * a3)) + ((a4 * a4 + a5 * a5) + (a6 * a6 + a7 * a7));
            if (Q8) am = fmaxf(fmaxf(fmaxf(am, fmaxf(fabsf(a0), fabsf(a1))), fmaxf(fabsf(a2), fabsf(a3))), fmaxf(fmaxf(fabsf(a4), fabsf(a5)), fmaxf(fabsf(a6), fabsf(a7)))); }
        ss = wave_sum(ss);
        const float rs = 1.0f / sqrtf(ss * (1.0f / D) + EPS);
        if (!Q8) { if (lane == 0) rstd[r] = rs; }
        else {
#pragma unroll
            for (int o = 1; o < 64; o <<= 1) am = fmaxf(am, __shfl_xor(am, o));
            const float inv = am > 0.f ? 127.0f / am : 0.f; if (lane == 0) rstd[r] = rs * am * (1.0f / 127.0f);
#pragma unroll
            for (int j = 0; j < 8; ++j) { const v4u w = wq[j]; unsigned lo, hi;
                { const int b0 = (int)rintf(bf2f(w.x & 0xffffu) * inv), b1 = (int)rintf(bf2f(w.x >> 16) * inv), b2 = (int)rintf(bf2f(w.y & 0xffffu) * inv), b3 = (int)rintf(bf2f(w.y >> 16) * inv);
                  lo = (unsigned)(b0 & 0xff) | ((unsigned)(b1 & 0xff) << 8) | ((unsigned)(b2 & 0xff) << 16) | ((unsigned)(b3 & 0xff) << 24); }
                { const int b0 = (int)rintf(bf2f(w.z & 0xffffu) * inv), b1 = (int)rintf(bf2f(w.z >> 16) * inv), b2 = (int)rintf(bf2f(w.w & 0xffffu) * inv), b3 = (int)rintf(bf2f(w.w >> 16) * inv);
                  hi = (unsigned)(b0 & 0xff) | ((unsigned)(b1 & 0xff) << 8) | ((unsigned)(b2 & 0xff) << 16) | ((unsigned)(b3 & 0xff) << 24); }
                ((v2u*)(A8 + (size_t)r * D))[lane + 64 * j] = (v2u){lo, hi}; }
        }
    }
}
__device__ __forceinline__ void final_phase(const bf16* Hprev, const bf16* HB3, float* out, const float* gain, const float* part, LAS float* red, int bx, int G, int gw, int NGW, int wave, int lane) {
    if (part) for (int hr = bx; hr < 256; hr += G) {
        const int r = M - 256 + hr, b = r / LP, p = r - b * LP;
        f32x4 v[2]; float ss = 0.f;
#pragma unroll
        for (int j = 0; j < 2; ++j) { const size_t c = (size_t)(512 * wave + 256 * j + 4 * lane); v[j] = bf4_to_f32(*(const v2u*)(Hprev + (size_t)r * D + c));
#pragma unroll
            for (int s = 0; s < 16; ++s) v[j] = v[j] + *(const f32x4*)(part + ((size_t)s * 256 + hr) * D + c);
            ss += (v[j].x * v[j].x + v[j].y * v[j].y) + (v[j].z * v[j].z + v[j].w * v[j].w); }
        ss = wave_sum(ss);
        if (lane == 0) red[wave] = ss;
        __syncthreads();
        float tot = 0.f;
#pragma unroll
        for (int w = 0; w < NWAVES; ++w) tot += red[w];
        __syncthreads();
        const float rs = 1.0f / sqrtf(tot * (1.0f / D) + EPS);
#pragma unroll
        for (int j = 0; j < 2; ++j) { const size_t c = (size_t)(512 * wave + 256 * j + 4 * lane); const f32x4 g = *(const f32x4*)(gain + c);
            *(f32x4*)(out + ((size_t)b * SEQ + (size_t)(p - 128)) * D + c) = v[j] * rs * g; }
    }
    for (int r = gw; r < (part ? M - 256 : M); r += NGW) {
        const int b = r / LP, p = r - b * LP;
        if (p < 128) continue;
        float ss = 0.f; v4u wq[8];
#pragma unroll
        for (int j = 0; j < 8; ++j) { const v4u w = ((const v4u*)(HB3 + (size_t)r * D))[lane + 64 * j]; wq[j] = w;
            const float a0 = bf2f(w.x & 0xffffu), a1 = bf2f(w.x >> 16), a2 = bf2f(w.y & 0xffffu), a3 = bf2f(w.y >> 16), a4 = bf2f(w.z & 0xffffu), a5 = bf2f(w.z >> 16), a6 = bf2f(w.w & 0xffffu), a7 = bf2f(w.w >> 16);
            ss += ((a0 * a0 + a1 * a1) + (a2 * a2 + a3 * a3)) + ((a4 * a4 + a5 * a5) + (a6 * a6 + a7 * a7)); }
        ss = wave_sum(ss);
        const float rs = 1.0f / sqrtf(ss * (1.0f / D) + EPS);
        float* orow = out + ((size_t)b * SEQ + (size_t)(p - 128)) * D;
#pragma unroll
        for (int j = 0; j < 8; ++j) { const v4u w = wq[j]; const int e0 = 8 * (lane + 64 * j);
            const f32x4 g0 = *(const f32x4*)(gain + e0), g1 = *(const f32x4*)(gain + e0 + 4);
            *(f32x4*)(orow + e0) = (f32x4){bf2f(w.x & 0xffffu), bf2f(w.x >> 16), bf2f(w.y & 0xffffu), bf2f(w.y >> 16)} * rs * g0;
            *(f32x4*)(orow + e0 + 4) = (f32x4){bf2f(w.z & 0xffffu), bf2f(w.z >> 16), bf2f(w.w & 0xffffu), bf2f(w.w >> 16)} * rs * g1; }
    }
}
constexpr int NSL = 16;
template <int MODE>
__device__ __forceinline__ void rows_phase(const float* x, const float* meta, float* H, bf16* XN, float* out, const float* gain, int gw, int NGW, int lane,
                                           const float* part = nullptr, LAS float* red = nullptr, int bx = 0, int G = 1, int wave = 0) {
    if (MODE != 0 && part) {
        for (int hr = bx; hr < 256; hr += G) {
            const int r = M - 256 + hr, b = r / LP, p = r - b * LP;
            f32x4 v[2]; float ss = 0.f;
#pragma unroll
            for (int j = 0; j < 2; ++j) { const size_t c = (size_t)(512 * wave + 256 * j + 4 * lane); v[j] = *(const f32x4*)(H + (size_t)r * D + c);
#pragma unroll
                for (int s = 0; s < NSL; ++s) v[j] = v[j] + *(const f32x4*)(part + ((size_t)s * 256 + hr) * D + c);
                if (MODE == 1) *(f32x4*)(H + (size_t)r * D + c) = v[j];
                ss += (v[j].x * v[j].x + v[j].y * v[j].y) + (v[j].z * v[j].z + v[j].w * v[j].w); }
            ss = wave_sum(ss);
            if (lane == 0) red[wave] = ss;
            __syncthreads();
            float tot = 0.f;
#pragma unroll
            for (int w = 0; w < NWAVES; ++w) tot += red[w];
            __syncthreads();
            const float rstd = 1.0f / sqrtf(tot * (1.0f / D) + EPS);
#pragma unroll
            for (int j = 0; j < 2; ++j) { const size_t c = (size_t)(512 * wave + 256 * j + 4 * lane); const f32x4 g = *(const f32x4*)(gain + c); const f32x4 y = v[j] * rstd * g;
                if (MODE == 1) { v2u w; w.x = pk2(y.x, y.y); w.y = pk2(y.z, y.w); *(v2u*)(XN + (size_t)r * D + c) = w; }
                else *(f32x4*)(out + ((size_t)b * SEQ + (size_t)(p - 128)) * D + c) = y; }
        }
    }
    const int MEND = (MODE != 0 && part) ? M - 256 : M;
    for (int r = gw; r < MEND; r += NGW) {
        const int b = r / LP, p = r - b * LP;
        if (MODE == 2 && p < 128) continue;
        const float* src; bool zero = false;
        if (MODE == 0) { if (p < NPAD) { zero = true; src = x; } else if (p < 128) src = meta + (size_t)(p - NPAD) * D; else src = x + ((size_t)b * SEQ + (size_t)(p - 128)) * D; }
        else src = H + (size_t)r * D;
        f32x4 v[16]; float ss = 0.f;
#pragma unroll
        for (int j = 0; j < 16; ++j) { v[j] = zero ? (f32x4){0.f, 0.f, 0.f, 0.f} : ((const f32x4*)src)[lane + 64 * j]; ss += (v[j].x * v[j].x + v[j].y * v[j].y) + (v[j].z * v[j].z + v[j].w * v[j].w); }
        ss = wave_sum(ss);
        const float rstd = 1.0f / sqrtf(ss * (1.0f / D) + EPS);
#pragma unroll
        for (int j = 0; j < 16; ++j) { const f32x4 g = ((const f32x4*)gain)[lane + 64 * j]; const f32x4 y = v[j] * rstd * g;
            if (MODE == 0) ((f32x4*)(H + (size_t)r * D))[lane + 64 * j] = v[j];
            if (MODE != 2) { v2u w; w.x = pk2(y.x, y.y); w.y = pk2(y.z, y.w); ((v2u*)(XN + (size_t)r * D))[lane + 64 * j] = w; }
            else ((f32x4*)(out + ((size_t)b * SEQ + (size_t)(p - 128)) * D))[lane + 64 * j] = y; }
    }
}
template <bool GU, bool HAS_GAIN = false>
__device__ __forceinline__ void transpose_item(const float* W, int K, int N, bf16* WT, LAS float* scr, int item, int lane, const float* gain = nullptr) {
    const int nblk = N / 32, kb = item / nblk, nb = item - kb * nblk, k0 = 64 * kb, n0 = 32 * nb;
    int drow0 = n0;
    if (GU) { const int hh = (n0 >= FF) ? 1 : 0, nn = n0 - hh * FF; drow0 = 256 * (nn >> 7) + 128 * hh + (nn & 127); }
    float wv[32];
#pragma unroll
    for (int i = 0; i < 32; ++i) wv[i] = W[(size_t)(k0 + 2 * i + (lane >> 5)) * N + n0 + (lane & 31)];
    if (HAS_GAIN) {
        float gv[32];
#pragma unroll
        for (int i = 0; i < 32; ++i) gv[i] = gain[k0 + 2 * i + (lane >> 5)];
#pragma unroll
        for (int i = 0; i < 32; ++i) wv[i] *= gv[i];
    }
#pragma unroll
    for (int i = 0; i < 32; ++i) scr[(2 * i + (lane >> 5)) * 33 + (lane & 31)] = wv[i];
    LDS_WAIT(); asm volatile("" ::: "memory");
    const int c = lane & 7;
#pragma unroll
    for (int j = 0; j < 4; ++j) { const int n = (lane >> 3) + 8 * j; const LAS float* s = scr + (8 * c) * 33 + n;
        v4u o; o.x = pk2(s[0 * 33], s[1 * 33]); o.y = pk2(s[2 * 33], s[3 * 33]); o.z = pk2(s[4 * 33], s[5 * 33]); o.w = pk2(s[6 * 33], s[7 * 33]);
        *(v4u*)(WT + (size_t)(drow0 + n) * K + k0 + 8 * c) = o; }
    LDS_WAIT(); asm volatile("" ::: "memory");
}

__device__ __forceinline__ void fwht32(float (&v)[32]) {
#pragma unroll
    for (int len = 1; len < 32; len <<= 1)
#pragma unroll
        for (int i = 0; i < 32; ++i) if (!(i & len)) { const float a = v[i], b = v[i + len]; v[i] = a + b; v[i + len] = a - b; }
#pragma unroll
    for (int i = 0; i < 32; ++i) v[i] *= 0.17677669529663687f;
}
__device__ __forceinline__ void transpose_item_rot(const float* W, int K, int N, bf16* WT, LAS float* scr, int item, int lane, unsigned* colmax_bits) {
    const int nblk = N / 32, kb = item / nblk, nb = item - kb * nblk, k0 = 64 * kb, n0 = 32 * nb;
    float wv[32];
#pragma unroll
    for (int i = 0; i < 32; ++i) wv[i] = W[(size_t)(k0 + 2 * i + (lane >> 5)) * N + n0 + (lane & 31)];
#pragma unroll
    for (int i = 0; i < 32; ++i) scr[(2 * i + (lane >> 5)) * 33 + (lane & 31)] = wv[i];
    LDS_WAIT(); asm volatile("" ::: "memory");
    { float v[32]; const int n = lane & 31, hb = 32 * (lane >> 5);
#pragma unroll
        for (int i = 0; i < 32; ++i) v[i] = scr[(hb + i) * 33 + n];
        fwht32(v);
        float m = 0.f;
#pragma unroll
        for (int i = 0; i < 32; ++i) { scr[(hb + i) * 33 + n] = v[i]; m = fmaxf(m, fabsf(v[i])); }
        if (colmax_bits) { m = fmaxf(m, __shfl_xor(m, 32)); if (lane < 32) atomicMax(colmax_bits + n0 + n, __float_as_uint(m)); } }
    LDS_WAIT(); asm volatile("" ::: "memory");
    const int c = lane & 7;
#pragma unroll
    for (int j = 0; j < 4; ++j) { const int n = (lane >> 3) + 8 * j; const LAS float* s = scr + (8 * c) * 33 + n;
        v4u o; o.x = pk2(s[0 * 33], s[1 * 33]); o.y = pk2(s[2 * 33], s[3 * 33]); o.z = pk2(s[4 * 33], s[5 * 33]); o.w = pk2(s[6 * 33], s[7 * 33]);
        *(v4u*)(WT + (size_t)(n0 + n) * K + k0 + 8 * c) = o; }
    LDS_WAIT(); asm volatile("" ::: "memory");
}
__device__ __forceinline__ unsigned q8pack(float a, float b, float c, float d, float inv) {
    const int b0 = (int)fminf(fmaxf(rintf(a * inv), -127.f), 127.f), b1 = (int)fminf(fmaxf(rintf(b * inv), -127.f), 127.f), b2 = (int)fminf(fmaxf(rintf(c * inv), -127.f), 127.f), b3 = (int)fminf(fmaxf(rintf(d * inv), -127.f), 127.f);
    return (unsigned)(b0 & 0xff) | ((unsigned)(b1 & 0xff) << 8) | ((unsigned)(b2 & 0xff) << 16) | ((unsigned)(b3 & 0xff) << 24);
}
__device__ __forceinline__ void rows_to_int8(const bf16* src, unsigned char* dst, const unsigned* maxbits, int nrows, int width, int gw, int NGW, int lane) {
    const int chunks = width / 8;
    for (int r = gw; r < nrows; r += NGW) {
        const float am = __uint_as_float(maxbits[r]), inv = am > 0.f ? 127.0f / am : 0.f;
        const v4u* s = (const v4u*)(src + (size_t)r * width); v2u* d = (v2u*)(dst + (size_t)r * width);
        for (int ci = lane; ci < chunks; ci += 64) { const v4u w = s[ci];
            v2u o; o.x = q8pack(bf2f(w.x & 0xffffu), bf2f(w.x >> 16), bf2f(w.y & 0xffffu), bf2f(w.y >> 16), inv); o.y = q8pack(bf2f(w.z & 0xffffu), bf2f(w.z >> 16), bf2f(w.w & 0xffffu), bf2f(w.w >> 16), inv);
            d[ci] = o; }
    }
}
constexpr int RQ_LANES = 4; constexpr float RQ_SCALE = 0.17677669529663687f;
__device__ __forceinline__ unsigned q8pack_fast(float a, float b, float c, float d, float s) {
    const unsigned t0 = __float_as_uint(fmaf(a, s, 12582912.0f)), t1 = __float_as_uint(fmaf(b, s, 12582912.0f)), t2 = __float_as_uint(fmaf(c, s, 12582912.0f)), t3 = __float_as_uint(fmaf(d, s, 12582912.0f));
    return __builtin_amdgcn_perm(__builtin_amdgcn_perm(t3, t2, 0x0c0c0400u), __builtin_amdgcn_perm(t1, t0, 0x0c0c0400u), 0x05040100u);
}
template <bool TOK>
__device__ __forceinline__ void act_rot_quant(const bf16* src, unsigned char* dst, unsigned* rowmax, int gw, int NGW, int lane) {
    constexpr int CH = FF / 8, NJ = (CH + 63) / 64;
    constexpr float RS = RQ_SCALE;
    for (int r = gw; r < M; r += NGW) {
        if (TOK && (r % LP) < 128) continue;
        const v4u* s = (const v4u*)(src + (size_t)r * FF); v2u* d = (v2u*)(dst + (size_t)r * FF);
        float v[NJ][8]; float am = 0.f;
#pragma unroll
        for (int j = 0; j < NJ; ++j) { const int ci = lane + 64 * j; v4u w = (v4u){0u, 0u, 0u, 0u}; if (ci < CH) w = s[ci];
            v[j][0] = __uint_as_float(w.x << 16); v[j][1] = __uint_as_float(w.x & 0xffff0000u); v[j][2] = __uint_as_float(w.y << 16); v[j][3] = __uint_as_float(w.y & 0xffff0000u);
            v[j][4] = __uint_as_float(w.z << 16); v[j][5] = __uint_as_float(w.z & 0xffff0000u); v[j][6] = __uint_as_float(w.w << 16); v[j][7] = __uint_as_float(w.w & 0xffff0000u); }
#pragma unroll
        for (int j = 0; j < NJ; ++j) {
#pragma unroll
            for (int len = 1; len < 8; len <<= 1)
#pragma unroll
                for (int i = 0; i < 8; ++i) if (!(i & len)) { const float x0 = v[j][i], x1 = v[j][i + len]; v[j][i] = x0 + x1; v[j][i + len] = x0 - x1; }
#pragma unroll
            for (int bit = 1; bit < RQ_LANES; bit <<= 1) { const float sg = (lane & bit) ? -1.0f : 1.0f;
#pragma unroll
                for (int i = 0; i < 8; ++i) v[j][i] = fmaf(v[j][i], sg, __shfl_xor(v[j][i], bit)); }
#pragma unroll
            for (int i = 0; i < 8; ++i) am = fmaxf(am, fabsf(v[j][i])); }
#pragma unroll
        for (int o = 1; o < 64; o <<= 1) am = fmaxf(am, __shfl_xor(am, o));
        const float qs = am > 0.f ? 127.0f / am : 0.f;
        if (lane == 0) rowmax[r] = __float_as_uint(am * RS);
#pragma unroll
        for (int j = 0; j < NJ; ++j) { const int ci = lane + 64 * j; v2u o; o.x = q8pack_fast(v[j][0], v[j][1], v[j][2], v[j][3], qs); o.y = q8pack_fast(v[j][4], v[j][5], v[j][6], v[j][7], qs); if (ci < CH) d[ci] = o; }
    }
}
__device__ __forceinline__ void colmax_item(const float* W, int K, int N, const float* gain, unsigned* colmax_bits, int item, int lane) {
    const int nblk = N / 32, kb = item / nblk, nb = item - kb * nblk, k0 = 64 * kb, n0 = 32 * nb;
    const int hh = (n0 >= FF) ? 1 : 0, nn = n0 - hh * FF, drow0 = 256 * (nn >> 7) + 128 * hh + (nn & 127);
    float wv[32], gv[32];
#pragma unroll
    for (int i = 0; i < 32; ++i) wv[i] = W[(size_t)(k0 + 2 * i + (lane >> 5)) * N + n0 + (lane & 31)];
#pragma unroll
    for (int i = 0; i < 32; ++i) gv[i] = gain[k0 + 2 * i + (lane >> 5)];
    float m = 0.f;
#pragma unroll
    for (int i = 0; i < 32; ++i) m = fmaxf(m, fabsf(wv[i] * gv[i]));
    m = fmaxf(m, __shfl_xor(m, 32));
    if (lane < 32) atomicMax(colmax_bits + drow0 + lane, __float_as_uint(m));
}
__device__ __forceinline__ void quant_item(const float* W, int K, int N, unsigned char* WT, LAS float* scr, int item, int lane, const float* gain, const float* colmax) {
    const int nblk = N / 32, kb = item / nblk, nb = item - kb * nblk, k0 = 64 * kb, n0 = 32 * nb;
    const int hh = (n0 >= FF) ? 1 : 0, nn = n0 - hh * FF, drow0 = 256 * (nn >> 7) + 128 * hh + (nn & 127);
    float wv[32], gv[32];
#pragma unroll
    for (int i = 0; i < 32; ++i) wv[i] = W[(size_t)(k0 + 2 * i + (lane >> 5)) * N + n0 + (lane & 31)];
#pragma unroll
    for (int i = 0; i < 32; ++i) gv[i] = gain[k0 + 2 * i + (lane >> 5)];
    const float cm = colmax[drow0 + (lane & 31)], inv = cm > 0.f ? 127.0f / cm : 0.f;
#pragma unroll
    for (int i = 0; i < 32; ++i) scr[(2 * i + (lane >> 5)) * 33 + (lane & 31)] = rintf((wv[i] * gv[i]) * inv);
    LDS_WAIT(); asm volatile("" ::: "memory");
    const int c = lane & 3;
#pragma unroll
    for (int ps = 0; ps < 2; ++ps) { const int n = (lane >> 2) + 16 * ps; const LAS float* s = scr + (16 * c) * 33 + n; unsigned wd[4];
#pragma unroll
        for (int w4 = 0; w4 < 4; ++w4) { const int b0 = (int)s[(4 * w4 + 0) * 33], b1 = (int)s[(4 * w4 + 1) * 33], b2 = (int)s[(4 * w4 + 2) * 33], b3 = (int)s[(4 * w4 + 3) * 33];
            wd[w4] = (unsigned)(b0 & 0xff) | ((unsigned)(b1 & 0xff) << 8) | ((unsigned)(b2 & 0xff) << 16) | ((unsigned)(b3 & 0xff) << 24); }
        *(v4u*)(WT + (size_t)(drow0 + n) * K + k0 + 16 * c) = (v4u){wd[0], wd[1], wd[2], wd[3]}; }
    LDS_WAIT(); asm volatile("" ::: "memory");
}
__device__ __forceinline__ void rows_init8(const float* x, const float* meta, unsigned char* XN8, float* rowfac, int gw, int NGW, int lane) {
    for (int r = gw; r < M; r += NGW) {
        const int b = r / LP, p = r - b * LP;
        const bool zero = p < NPAD; const float* src = (p < 128) ? meta + (size_t)(zero ? 0 : p - NPAD) * D : x + ((size_t)b * SEQ + (size_t)(p - 128)) * D;
        f32x4 v[16]; float ss = 0.f, am = 0.f;
#pragma unroll
        for (int j = 0; j < 16; ++j) { v[j] = zero ? (f32x4){0.f, 0.f, 0.f, 0.f} : ((const f32x4*)src)[lane + 64 * j]; ss += (v[j].x * v[j].x + v[j].y * v[j].y) + (v[j].z * v[j].z + v[j].w * v[j].w);
            am = fmaxf(fmaxf(am, fmaxf(fabsf(v[j].x), fabsf(v[j].y))), fmaxf(fabsf(v[j].z), fabsf(v[j].w))); }
        ss = wave_sum(ss);
#pragma unroll
        for (int o = 1; o < 64; o <<= 1) am = fmaxf(am, __shfl_xor(am, o));
        const float rs = 1.0f / sqrtf(ss * (1.0f / D) + EPS), amn = am * rs, inv = amn > 0.f ? 127.0f / amn : 0.f, sc = rs * inv;
        if (lane == 0) rowfac[r] = amn * (1.0f / 127.0f);
#pragma unroll
        for (int j = 0; j < 16; ++j) { const int b0 = (int)rintf(v[j].x * sc), b1 = (int)rintf(v[j].y * sc), b2 = (int)rintf(v[j].z * sc), b3 = (int)rintf(v[j].w * sc);
            ((unsigned*)(XN8 + (size_t)r * D))[lane + 64 * j] = (unsigned)(b0 & 0xff) | ((unsigned)(b1 & 0xff) << 8) | ((unsigned)(b2 & 0xff) << 16) | ((unsigned)(b3 & 0xff) << 24); }
    }
}

__device__ __forceinline__ void attn_unit(LAS unsigned char* lds, const bf16* PROJ, bf16* MG, const float* sinks, int b, int n, int g, int tid, int wave, int lane) {
    asm volatile("" : "+v"(tid), "+v"(lane));
    constexpr int RS = 160;
    LAS unsigned char* Kl = lds; LAS unsigned char* Vl = lds + 256 * RS;
    const long row_first = (long)b * LP + (long)(n - 1) * 128;
    { v4u kr[4], vr[4];
#pragma unroll
    for (int it = 0; it < 4; ++it) { const int c = tid + 512 * it, j = c >> 3, ch = c & 7;
        kr[it] = (v4u){0u, 0u, 0u, 0u}; vr[it] = (v4u){0u, 0u, 0u, 0u};
        if (n > 0 || j >= 128) { const bf16* rp = PROJ + (size_t)(row_first + j) * INW + 64 * g + 8 * ch; kr[it] = *(const v4u*)(rp + OFF_KA); vr[it] = *(const v4u*)(rp + OFF_VA); } }
#pragma unroll
    for (int it = 0; it < 4; ++it) { const int c = tid + 512 * it, j = c >> 3, ch = c & 7;
        *(LAS v4u*)(Kl + j * RS + 16 * ch) = kr[it]; *(LAS v4u*)(Vl + j * RS + 16 * ch) = vr[it]; } }
    __syncthreads();
    const int hq = 8 * g + wave, fr = lane & 15, q = lane >> 4, ta = fr >> 2, tp = lane & 3;
    const float slope2 = exp2f(-0.25f * (float)(hq + 1)) * LOG2E;
    const float sink2 = sinks[hq] * LOG2E;
    const float qscale = 0.125f * LOG2E;
    bf16x8 qn[2];
    { const size_t qrow = (size_t)b * LP + (size_t)n * 128 + (size_t)((n == 0 ? 112 : 0) + fr);
#pragma unroll
      for (int s = 0; s < 2; ++s) qn[s] = *(const bf16x8*)(PROJ + qrow * INW + OFF_QA + hq * 64 + 32 * s + 8 * q); }
    for (int qt = 0; qt < 8; ++qt) {
        if (n == 0 && qt < 7) {
            const size_t qrow0z = (size_t)b * LP + (size_t)(16 * qt);
#pragma unroll
            for (int k = 0; k < 2; ++k) { const int c = lane + 64 * k, row = c >> 3, ch = c & 7; *(v4u*)(MG + (qrow0z + row) * D + hq * 64 + 8 * ch) = (v4u){0u, 0u, 0u, 0u}; }
            continue; }
        const int i = 16 * qt + fr; const size_t qrow = (size_t)b * LP + (size_t)n * 128 + (size_t)i;
        bf16x8 qf[2];
#pragma unroll
        for (int s = 0; s < 2; ++s) qf[s] = qn[s];
        { const size_t qrown = qrow + (qt < 7 ? 16 : 0);
#pragma unroll
          for (int s = 0; s < 2; ++s) qn[s] = *(const bf16x8*)(PROJ + qrown * INW + OFF_QA + hq * 64 + 32 * s + 8 * q); }
        f32x4 sc[9];
#pragma unroll
        for (int t = 0; t < 9; ++t) { const LAS unsigned char* kp = Kl + (16 * (qt + t) + fr) * RS + 16 * q; f32x4 a = (f32x4){0.f, 0.f, 0.f, 0.f};
#pragma unroll
            for (int s = 0; s < 2; ++s) a = MFMA16(*(const LAS bf16x8*)(kp + 64 * s), qf[s], a);
            sc[t] = a; }
        float mx = -1e30f;
#pragma unroll
        for (int t = 0; t < 9; ++t)
#pragma unroll
            for (int r = 0; r < 4; ++r) { const int j = 16 * (qt + t) + 4 * q + r, dist = 128 + i - j, kpos = (n - 1) * 128 + j; const bool ok = dist >= 0 && dist < 128 && kpos >= NPAD;
                const float val = ok ? sc[t][r] * qscale - slope2 * (float)dist : -1e30f; sc[t][r] = val; mx = fmaxf(mx, val); }
        mx = fmaxf(mx, __shfl_xor(mx, 16)); mx = fmaxf(mx, __shfl_xor(mx, 32));
        const float m2 = fmaxf(mx, sink2);
        float sum = 0.f;
#pragma unroll
        for (int t = 0; t < 9; ++t)
#pragma unroll
            for (int r = 0; r < 4; ++r) { const float p = __builtin_amdgcn_exp2f(sc[t][r] - m2); sc[t][r] = p; sum += p; }
        sum += __shfl_xor(sum, 16); sum += __shfl_xor(sum, 32);
        const float inv = 1.0f / (sum + __builtin_amdgcn_exp2f(sink2 - m2));
        f32x4 o[4];
#pragma unroll
        for (int dt = 0; dt < 4; ++dt) o[dt] = (f32x4){0.f, 0.f, 0.f, 0.f};
#pragma unroll
        for (int sp = 0; sp < 5; ++sp) { const int T0 = qt + 2 * sp; int T1 = T0 + 1; if (T1 > 15) T1 = 15;
            v4u pw; pw.x = pk2(sc[2 * sp][0], sc[2 * sp][1]); pw.y = pk2(sc[2 * sp][2], sc[2 * sp][3]);
            if (2 * sp + 1 < 9) { pw.z = pk2(sc[(2 * sp + 1) % 9][0], sc[(2 * sp + 1) % 9][1]); pw.w = pk2(sc[(2 * sp + 1) % 9][2], sc[(2 * sp + 1) % 9][3]); } else { pw.z = 0u; pw.w = 0u; }
            const bf16x8 pb = __builtin_bit_cast(bf16x8, pw);
#pragma unroll
            for (int dt = 0; dt < 4; ++dt) { const s16x4 lo = ds_tr16(Vl + (16 * T0 + 4 * q + ta) * RS + (16 * dt + 4 * tp) * 2), hi = ds_tr16(Vl + (16 * T1 + 4 * q + ta) * RS + (16 * dt + 4 * tp) * 2);
                o[dt] = MFMA16(cat8(lo, hi), pb, o[dt]); } }
        LAS unsigned char* Ow = lds + 81920 + wave * 2304;
#pragma unroll
        for (int dt = 0; dt < 4; ++dt) { const f32x4 ov = o[dt] * inv; v2u w; w.x = pk2(ov[0], ov[1]); w.y = pk2(ov[2], ov[3]); *(LAS v2u*)(Ow + fr * 144 + (16 * dt + 4 * q) * 2) = w; }
        LDS_WAIT();
        const size_t qrow0 = (size_t)b * LP + (size_t)n * 128 + (size_t)(16 * qt);
#pragma unroll
        for (int k = 0; k < 2; ++k) { const int c = lane + 64 * k, row = c >> 3, ch = c & 7; const v4u v = *(const LAS v4u*)(Ow + row * 144 + 16 * ch); *(v4u*)(MG + (qrow0 + row) * D + hq * 64 + 8 * ch) = v; }
        LDS_WAIT();
    }
    __syncthreads();
}

__device__ __forceinline__ void kv_unit(LAS unsigned char* lds, const bf16* PROJ, bf16* ST, int b, int h, int n, int tid, int wave, int lane) {
    asm volatile("" : "+v"(tid), "+v"(lane));
    constexpr int RS = 544;
    LAS unsigned char* Kl = lds; LAS unsigned char* Vl = lds + 128 * RS;
    const float lg = log2_gamma(h);
    const size_t row0 = (size_t)b * LP + (size_t)n * 128;
    v4u kr[8], vr[8];
#pragma unroll
    for (int it = 0; it < 8; ++it) { const int c = tid + 512 * it, j = c >> 5, ch = c & 31; const bf16* rp = PROJ + (row0 + j) * INW + 256 * h + 8 * ch;
        kr[it] = *(const v4u*)(rp + OFF_KR); vr[it] = *(const v4u*)(rp + OFF_VR); }
#pragma unroll
    for (int it = 0; it < 8; ++it) { const int c = tid + 512 * it, j = c >> 5, ch = c & 31;
        v4u kv = kr[it]; const v4u vv = vr[it];
        const float w = __builtin_amdgcn_exp2f((float)(127 - j) * lg) * 0.0625f;
        kv.x = pk2(bf2f(kv.x & 0xffffu) * w, bf2f(kv.x >> 16) * w); kv.y = pk2(bf2f(kv.y & 0xffffu) * w, bf2f(kv.y >> 16) * w);
        kv.z = pk2(bf2f(kv.z & 0xffffu) * w, bf2f(kv.z >> 16) * w); kv.w = pk2(bf2f(kv.w & 0xffffu) * w, bf2f(kv.w >> 16) * w);
        *(LAS v4u*)(Kl + j * RS + 16 * ch) = kv; *(LAS v4u*)(Vl + j * RS + 16 * ch) = vv; }
    __syncthreads();
    const int fr = lane & 15, q = lane >> 4, ta = fr >> 2, tp = lane & 3;
    const int dt0 = 4 * (wave & 3), et0 = 8 * (wave >> 2);
    f32x4 acc[4][8];
#pragma unroll
    for (int a = 0; a < 4; ++a)
#pragma unroll
        for (int e = 0; e < 8; ++e) acc[a][e] = (f32x4){0.f, 0.f, 0.f, 0.f};
#pragma unroll
    for (int s = 0; s < 4; ++s) {
        bf16x8 af[4], bfr[8];
#pragma unroll
        for (int a = 0; a < 4; ++a) { const LAS unsigned char* p = Kl + (32 * s + 8 * q + ta) * RS + (16 * (dt0 + a) + 4 * tp) * 2; af[a] = cat8(ds_tr16(p), ds_tr16(p + 4 * RS)); }
#pragma unroll
        for (int e = 0; e < 8; ++e) { const LAS unsigned char* p = Vl + (32 * s + 8 * q + ta) * RS + (16 * (et0 + e) + 4 * tp) * 2; bfr[e] = cat8(ds_tr16(p), ds_tr16(p + 4 * RS)); }
#pragma unroll
        for (int a = 0; a < 4; ++a)
#pragma unroll
            for (int e = 0; e < 8; ++e) acc[a][e] = MFMA16(af[a], bfr[e], acc[a][e]);
    }
    bf16* sp = ST + ((size_t)(n * 2 + b) * 8 + h) * 65536;
    __syncthreads();
#pragma unroll
    for (int a = 0; a < 4; ++a)
#pragma unroll
        for (int e = 0; e < 8; ++e) { v2u w; w.x = pk2(acc[a][e][0], acc[a][e][1]); w.y = pk2(acc[a][e][2], acc[a][e][3]); *(LAS v2u*)(lds + (16 * (et0 + e) + fr) * 528 + (16 * (dt0 + a) + 4 * q) * 2) = w; }
    __syncthreads();
#pragma unroll
    for (int it = 0; it < 16; ++it) { const int c = tid + 512 * it, row = ((c >> 5) + 37 * (int)blockIdx.x) & 255, ch = c & 31; const v4u v = *(const LAS v4u*)(lds + row * 528 + 16 * ch); *(v4u*)(sp + (size_t)row * 256 + 8 * ch) = v; }
    __syncthreads();
}
#define BAR_LDS() asm volatile("s_waitcnt lgkmcnt(0)\n\ts_barrier" ::: "memory")
__device__ __forceinline__ void kv_phase(LAS unsigned char* lds, const bf16* PROJ, bf16* ST, int bx, int G, int tid, int wave, int lane) {
    asm volatile("" : "+v"(tid), "+v"(lane));
    constexpr int RS = 544;
    LAS unsigned char* Kl = lds; LAS unsigned char* Vl = lds + 128 * RS;
    const int dt0 = 4 * (wave & 3), et0 = 8 * (wave >> 2);
    v4u kr[8], vr[8];
#define KV_LOAD(u_) do { const int b_ = ((u_) & 15) >> 3, h_ = (u_) & 7, n_ = (u_) >> 4; const size_t r0_ = (size_t)b_ * LP + (size_t)n_ * 128; \
        _Pragma("unroll") for (int it = 0; it < 8; ++it) { const int c = tid + 512 * it, j = c >> 5, ch = c & 31; const bf16* rp = PROJ + (r0_ + j) * INW + 256 * h_ + 8 * ch; \
            kr[it] = *(const v4u*)(rp + OFF_KR); vr[it] = *(const v4u*)(rp + OFF_VR); } } while (0)
    int u = bx;
    if (u < 1024) KV_LOAD(u);
    for (; u < 1024; u += G) {
        asm volatile("" : "+v"(tid), "+v"(lane));
        const int fr = lane & 15, q = lane >> 4, ta = fr >> 2, tp = lane & 3;
        const int b = (u & 15) >> 3, h = u & 7, n = u >> 4;
        const float lg = log2_gamma(h);
#pragma unroll
        for (int it = 0; it < 8; ++it) { const int c = tid + 512 * it, j = c >> 5, ch = c & 31;
            v4u kv = kr[it]; const v4u vv = vr[it];
            const float w = __builtin_amdgcn_exp2f((float)(127 - j) * lg) * 0.0625f;
            kv.x = pk2(bf2f(kv.x & 0xffffu) * w, bf2f(kv.x >> 16) * w); kv.y = pk2(bf2f(kv.y & 0xffffu) * w, bf2f(kv.y >> 16) * w);
            kv.z = pk2(bf2f(kv.z & 0xffffu) * w, bf2f(kv.z >> 16) * w); kv.w = pk2(bf2f(kv.w & 0xffffu) * w, bf2f(kv.w >> 16) * w);
            *(LAS v4u*)(Kl + j * RS + 16 * ch) = kv; *(LAS v4u*)(Vl + j * RS + 16 * ch) = vv; }
        BAR_LDS();
        f32x4 acc[4][8];
#pragma unroll
        for (int a = 0; a < 4; ++a)
#pragma unroll
            for (int e = 0; e < 8; ++e) acc[a][e] = (f32x4){0.f, 0.f, 0.f, 0.f};
#pragma unroll
        for (int s = 0; s < 4; ++s) {
            bf16x8 af[4], bfr[8];
#pragma unroll
            for (int a = 0; a < 4; ++a) { const LAS unsigned char* p = Kl + (32 * s + 8 * q + ta) * RS + (16 * (dt0 + a) + 4 * tp) * 2; af[a] = cat8(ds_tr16(p), ds_tr16(p + 4 * RS)); }
#pragma unroll
            for (int e = 0; e < 8; ++e) { const LAS unsigned char* p = Vl + (32 * s + 8 * q + ta) * RS + (16 * (et0 + e) + 4 * tp) * 2; bfr[e] = cat8(ds_tr16(p), ds_tr16(p + 4 * RS)); }
#pragma unroll
            for (int a = 0; a < 4; ++a)
#pragma unroll
                for (int e = 0; e < 8; ++e) acc[a][e] = MFMA16(af[a], bfr[e], acc[a][e]);
        }
        v2u pk[4][8];
#pragma unroll
        for (int a = 0; a < 4; ++a)
#pragma unroll
            for (int e = 0; e < 8; ++e) { pk[a][e].x = pk2(acc[a][e][0], acc[a][e][1]); pk[a][e].y = pk2(acc[a][e][2], acc[a][e][3]); }
        __builtin_amdgcn_sched_barrier(0);
        { const int un = (u + G < 1024) ? u + G : u; KV_LOAD(un); }
        __builtin_amdgcn_sched_barrier(0);
        bf16* sp = ST + ((size_t)(n * 2 + b) * 8 + h) * 65536;
        BAR_LDS();
#pragma unroll
        for (int a = 0; a < 4; ++a)
#pragma unroll
            for (int e = 0; e < 8; ++e) *(LAS v2u*)(lds + (16 * (et0 + e) + fr) * 528 + (16 * (dt0 + a) + 4 * q) * 2) = pk[a][e];
        BAR_LDS();
#pragma unroll
        for (int it = 0; it < 16; ++it) { const int c = tid + 512 * it, row = ((c >> 5) + 37 * bx) & 255, ch = c & 31; const v4u v = *(const LAS v4u*)(lds + row * 528 + 16 * ch); *(v4u*)(sp + (size_t)row * 256 + 8 * ch) = v; }
        BAR_LDS();
    }
#undef KV_LOAD
}
__device__ __forceinline__ void scan_phase(bf16* ST, int gtid, int nthreads) {
    for (int idx = gtid; idx < 16 * 8192; idx += nthreads) {
        const int bh = idx >> 13, v = idx & 8191, h = bh & 7;
        const float cd = exp2f(128.0f * log2_gamma(h));
        bf16* p = ST + (size_t)bh * 65536 + (size_t)v * 8; constexpr size_t NS = (size_t)16 * 65536;
        float s[8];
#pragma unroll
        for (int k = 0; k < 8; ++k) s[k] = 0.f;
        for (int nb = 0; nb < NCH; nb += 13) {
            v4u in[13];
#pragma unroll
            for (int k = 0; k < 13; ++k) in[k] = (nb + k < NCH - 1) ? *(const v4u*)(p + (size_t)(nb + k) * NS) : (v4u){0u, 0u, 0u, 0u};
#pragma unroll
            for (int k = 0; k < 13; ++k) { v4u o; o.x = pk2(s[0], s[1]); o.y = pk2(s[2], s[3]); o.z = pk2(s[4], s[5]); o.w = pk2(s[6], s[7]); *(v4u*)(p + (size_t)(nb + k) * NS) = o;
                s[0] = s[0] * cd + bf2f(in[k].x & 0xffffu); s[1] = s[1] * cd + bf2f(in[k].x >> 16); s[2] = s[2] * cd + bf2f(in[k].y & 0xffffu); s[3] = s[3] * cd + bf2f(in[k].y >> 16);
                s[4] = s[4] * cd + bf2f(in[k].z & 0xffffu); s[5] = s[5] * cd + bf2f(in[k].z >> 16); s[6] = s[6] * cd + bf2f(in[k].w & 0xffffu); s[7] = s[7] * cd + bf2f(in[k].w >> 16); }
        }
    }
}
__device__ __forceinline__ void ret_unit(LAS unsigned char* lds, const bf16* PROJ, const bf16* ST, bf16* MG, int b, int h, int n, int tid, int wave, int lane) {
    asm volatile("" : "+v"(tid), "+v"(lane));
    constexpr int RS = 544, SRS = 528, SBUF = 64 * SRS;
    LAS unsigned char* Kl = lds; LAS unsigned char* Vl = lds + 128 * RS;
    const float lg = log2_gamma(h);
    const size_t row0 = (size_t)b * LP + (size_t)n * 128;
    const bf16* sp = ST + ((size_t)(n * 2 + b) * 8 + h) * 65536;
    v4u sr[4];
#define RET_LOADST(c) do { _Pragma("unroll") for (int i_ = 0; i_ < 4; ++i_) { const int pc_ = tid + 512 * i_; sr[i_] = *(const v4u*)(sp + (size_t)(64 * (c) + (pc_ >> 5)) * 256 + 8 * (pc_ & 31)); } } while (0)
#define RET_WRITEST(buf) do { _Pragma("unroll") for (int i_ = 0; i_ < 4; ++i_) { const int pc_ = tid + 512 * i_; *(LAS v4u*)(Kl + (buf) * SBUF + (pc_ >> 5) * SRS + 16 * (pc_ & 31)) = sr[i_]; } } while (0)
    RET_LOADST(0);
    { v4u kr[8], vr[8];
#pragma unroll
    for (int it = 0; it < 8; ++it) { const int c = tid + 512 * it, j = c >> 5, ch = c & 31; const bf16* rp = PROJ + (row0 + j) * INW + 256 * h + 8 * ch;
        kr[it] = *(const v4u*)(rp + OFF_KR); vr[it] = *(const v4u*)(rp + OFF_VR); }
#pragma unroll
    for (int it = 0; it < 8; ++it) { const int c = tid + 512 * it, j = c >> 5, ch = c & 31;
        *(LAS v4u*)(Kl + j * RS + 16 * ch) = kr[it]; *(LAS v4u*)(Vl + j * RS + 16 * ch) = vr[it]; } }
    __syncthreads();
    const int fr = lane & 15, q = lane >> 4, ta = fr >> 2, tp = lane & 3;
    const int i = 16 * wave + fr; const size_t qrow = row0 + (size_t)i;
    bf16x8 qf[8];
#pragma unroll
    for (int s = 0; s < 8; ++s) qf[s] = *(const bf16x8*)(PROJ + qrow * INW + OFF_QR + 256 * h + 32 * s + 8 * q);
    v2u spk[8];
    const bool live = (n > 0) || (wave == NWAVES - 1);
#pragma unroll
    for (int jt = 0; jt < 8; ++jt) { f32x4 a = (f32x4){0.f, 0.f, 0.f, 0.f};
        if (jt <= wave && live) { const LAS unsigned char* kp = Kl + (16 * jt + fr) * RS + 16 * q;
#pragma unroll
            for (int s = 0; s < 8; ++s) a = MFMA16(*(const LAS bf16x8*)(kp + 64 * s), qf[s], a);
#pragma unroll
            for (int r = 0; r < 4; ++r) { const int j = 16 * jt + 4 * q + r; a[r] = (i >= j) ? a[r] * __builtin_amdgcn_exp2f((float)(i - j) * lg) * 0.0625f : 0.f; } }
        spk[jt].x = pk2(a[0], a[1]); spk[jt].y = pk2(a[2], a[3]); }
    __syncthreads();
    RET_WRITEST(0); RET_LOADST(1);
    __syncthreads();
    f32x4 acc[16];
#pragma unroll
    for (int et = 0; et < 16; ++et) acc[et] = (f32x4){0.f, 0.f, 0.f, 0.f};
#pragma unroll
    for (int c = 0; c < 4; ++c) {
        const LAS unsigned char* sb = Kl + (c & 1) * SBUF + fr * SRS + 16 * q;
        if (live) {
#pragma unroll
        for (int e4 = 0; e4 < 4; ++e4)
#pragma unroll
            for (int s = 0; s < 8; ++s) acc[4 * c + e4] = MFMA16(*(const LAS bf16x8*)(sb + 16 * e4 * SRS + 64 * s), qf[s], acc[4 * c + e4]);
        }
        if (c < 3) { RET_WRITEST((c + 1) & 1); if (c < 2) RET_LOADST(c + 2); __syncthreads(); }
    }
#undef RET_LOADST
#undef RET_WRITEST
    const float cw = __builtin_amdgcn_exp2f((float)(i + 1) * lg);
#pragma unroll
    for (int et = 0; et < 16; ++et) acc[et] = acc[et] * cw;
#pragma unroll
    for (int s2 = 0; s2 < 4; ++s2)
        if (2 * s2 <= wave && live) { v4u pw; pw.x = spk[2 * s2].x; pw.y = spk[2 * s2].y; pw.z = spk[2 * s2 + 1].x; pw.w = spk[2 * s2 + 1].y; const bf16x8 pb = __builtin_bit_cast(bf16x8, pw);
#pragma unroll
            for (int et = 0; et < 16; ++et) { const LAS unsigned char* p = Vl + (32 * s2 + 4 * q + ta) * RS + (16 * et + 4 * tp) * 2; acc[et] = MFMA16(cat8(ds_tr16(p), ds_tr16(p + 16 * RS)), pb, acc[et]); } }
    float ss = 0.f;
#pragma unroll
    for (int et = 0; et < 16; ++et) ss += (acc[et][0] * acc[et][0] + acc[et][1] * acc[et][1]) + (acc[et][2] * acc[et][2] + acc[et][3] * acc[et][3]);
    ss += __shfl_xor(ss, 16); ss += __shfl_xor(ss, 32);
    const float rstd = 1.0f / sqrtf(ss * (1.0f / 256.0f) + EPS);
    __syncthreads();
    LAS unsigned char* Rw = lds + wave * 16640;
#pragma unroll
    for (int et = 0; et < 16; ++et) *(LAS f32x4*)(Rw + fr * 1040 + (16 * et + 4 * q) * 4) = acc[et] * rstd;
    LDS_WAIT();
#pragma unroll
    for (int k = 0; k < 8; ++k) { const int c = lane + 64 * k, row = c >> 5, ch = c & 31; const size_t grow = row0 + (size_t)(16 * wave + row);
        const f32x4 a0 = *(const LAS f32x4*)(Rw + row * 1040 + 32 * ch), a1 = *(const LAS f32x4*)(Rw + row * 1040 + 32 * ch + 16);
        const v4u gw = *(const v4u*)(PROJ + grow * INW + OFF_GR + 256 * h + 8 * ch);
        v4u w; w.x = pk2(a0[0] * pg8::silu_f(bf2f(gw.x & 0xffffu)), a0[1] * pg8::silu_f(bf2f(gw.x >> 16))); w.y = pk2(a0[2] * pg8::silu_f(bf2f(gw.y & 0xffffu)), a0[3] * pg8::silu_f(bf2f(gw.y >> 16)));
        w.z = pk2(a1[0] * pg8::silu_f(bf2f(gw.z & 0xffffu)), a1[1] * pg8::silu_f(bf2f(gw.z >> 16))); w.w = pk2(a1[2] * pg8::silu_f(bf2f(gw.w & 0xffffu)), a1[3] * pg8::silu_f(bf2f(gw.w >> 16)));
        *(v4u*)(MG + grow * D + 2048 + 256 * h + 8 * ch) = w; }
    __syncthreads();
}

template <bool GU, bool HAS_GAIN>
__device__ __forceinline__ void convert_in_tail(int nunits, int G, int bx, int wave, int lane, const float* W, int K, int N, bf16* WT, LAS float* scr, const float* gain) {
    const int rounds = (nunits + G - 1) / G, nidle = rounds * G - nunits;
    int first = G - nidle, nconv = nidle; if (nidle < 8) { first = 0; nconv = G; }
    if (bx < first) return;
    const int nitems = (K / 64) * (N / 32);
    for (int it = (bx - first) * NWAVES + wave; it < nitems; it += nconv * NWAVES) transpose_item<GU, HAS_GAIN>(W, K, N, WT, scr, it, lane, gain);
}

constexpr int N_PHASES = 13;
#ifndef PROBE_REPS
#define PROBE_REPS {1,1,1,1,1,1,1,1,1,1,1,1,1}
#endif
#ifndef PROBE_T4
#define PROBE_T4 1
#endif
constexpr int REP[N_PHASES] = PROBE_REPS;
struct Args { const float* in[14]; float* out; unsigned char* ws; int ph_lo, ph_hi; };
__global__ void __launch_bounds__(NWAVES * 64, 2) hybrid_fwd(Args args) {
    extern __shared__ __attribute__((aligned(16))) unsigned char lds_raw[];
    LAS unsigned char* lds = (LAS unsigned char*)lds_raw;
    volatile LAS unsigned* MISC = (volatile LAS unsigned*)(lds + MISC_OFF);
    const int tid = threadIdx.x, lane = tid & 63, wave = __builtin_amdgcn_readfirstlane(tid >> 6);
    const int G = gridDim.x, bx = blockIdx.x, vcu = (G % 8 == 0) ? (bx % 8) * (G / 8) + bx / 8 : bx;
    const int gw = vcu * NWAVES + wave, NGW = G * NWAVES;
    unsigned char* ws = args.ws;
    const float* x = args.in[0]; const float* meta = args.in[1]; const float* g_ffn1 = args.in[2]; const float* w_gu1 = args.in[3]; const float* w_d1 = args.in[4];
    const float* g_mix = args.in[5]; const float* w_in = args.in[6]; const float* b_in = args.in[7]; const float* sinks = args.in[8]; const float* w_out = args.in[9];
    const float* g_ffn2 = args.in[10]; const float* w_gu2 = args.in[11]; const float* w_d2 = args.in[12]; const float* g_fin = args.in[13];
    bf16* HB1 = (bf16*)(ws + WS_H); bf16* HB3 = (bf16*)(ws + WS_H + 130 * MiB);
    bf16* XN = (bf16*)(ws + WS_XN); bf16* ACT = (bf16*)(ws + WS_ACT); bf16* PROJ = ACT; bf16* MG = XN; float* SQ1 = (float*)(ws + WS_ST + 32 * MiB);
    bf16* HB2 = (bf16*)(ws + WS_HB2); float* RSTD = (float*)(ws + WS_RSTD);
    bf16* WGU = (bf16*)(ws + WS_WGU); bf16* WD = (bf16*)(ws + WS_WD); bf16* WIN = (bf16*)(ws + WS_WIN); bf16* WOUT = (bf16*)(ws + WS_WOUT); bf16* ST = (bf16*)(ws + WS_ST);
    for (int u = tid; u < (LDS_BYTES - MISC_OFF) / 4; u += NWAVES * 64) ((LAS unsigned*)(lds + MISC_OFF))[u] = 0u;
    __syncthreads();
    const int lo = args.ph_lo, hi = args.ph_hi;
    XcdBarrier bar; bar.bar = (unsigned*)(ws + WS_CTL) + CW_BAR; bar.x = 0; bar.st = MISC + 8;
    if (hi - lo > 1) bar = xcd_barrier_post((unsigned*)(ws + WS_CTL) + CW_BAR, MISC + 8);
#define IN(k) (lo <= (k) && (k) < hi)
#define SEAM(k) do { if (IN(k) && IN((k) + 1)) xcd_barrier(bar); } while (0)
    LAS float* scr = (LAS float*)(lds + wave * 16384);
    LAS float* red = (LAS float*)(lds + 135168);

    unsigned* ROWMAXD1 = (unsigned*)(ws + WS_ROWMAXD1); unsigned* ROWMAXD2 = (unsigned*)(ws + WS_ROWMAXD2); float* COLMAXD1 = (float*)(ws + WS_COLMAXD1); float* COLMAXD2 = (float*)(ws + WS_COLMAXD2);
    unsigned char* ACT8 = (unsigned char*)(ws + WS_XN); unsigned char* WD8 = (unsigned char*)(ws + WS_WD8);
    float* ROWFAC = (float*)(ws + WS_ROWFAC); float* COLMAX1 = (float*)(ws + WS_COLMAX1); float* COLMAX2 = (float*)(ws + WS_COLMAX2);
    unsigned char* XN8 = (unsigned char*)XN; unsigned char* WGU8 = (unsigned char*)WGU; unsigned char* WGU8b = WGU8 + (size_t)NGU * D;
    if (IN(0)) {
        constexpr int I_GU = (D / 64) * (NGU / 32), I_D = (FF / 64) * (D / 32), I_IN = (D / 64) * (INW / 32);
        for (int it = gw; it < 2 * I_GU + I_D + I_IN; it += NGW) { int r = it;
            if (r < I_GU) { colmax_item(w_gu1, D, NGU, g_ffn1, (unsigned*)COLMAX1, r, lane); continue; } r -= I_GU;
            if (r < I_GU) { colmax_item(w_gu2, D, NGU, g_ffn2, (unsigned*)COLMAX2, r, lane); continue; } r -= I_GU;
            if (r < I_D) { transpose_item_rot(w_d1, FF, D, WD, scr, r, lane, (unsigned*)COLMAXD1); continue; } r -= I_D;
            transpose_item<false, true>(w_in, D, INW, WIN, scr, r, lane, g_mix); }
        rows_init8(x, meta, XN8, ROWFAC, gw, NGW, lane);
        xcd_barrier(bar);
        for (int it = gw; it < I_GU; it += NGW) quant_item(w_gu1, D, NGU, WGU8, scr, it, lane, g_ffn1, COLMAX1);
        rows_to_int8(WD, WD8, (const unsigned*)COLMAXD1, D, FF, gw, NGW, lane);
    }
    SEAM(0);
    if (IN(1)) for (int rep = 0; rep < REP[1]; ++rep) { pg8::Gemm g{(const bf16*)XN8, (const bf16*)WGU8, M, NGU, D}; pg8::StaticOrder S; S.init(M, NGU, G, bx); pg8::EpiSwiGLU8 E{ACT, FF, ROWFAC, COLMAX1};
        pg8::gemm_phase<pg8::EpiSwiGLU8, pg8::StaticOrder, true, true, true>(lds, g, S, E);
        convert_in_tail<false, false>((M / 256) * (NGU / 256), G, bx, wave, lane, w_out, D, D, WOUT, scr, nullptr);
        xcd_barrier(bar);
        act_rot_quant<false>(ACT, ACT8, ROWMAXD1, gw, NGW, lane); }
    SEAM(1);
    if (IN(2)) for (int rep = 0; rep < REP[2]; ++rep) { pg8::Gemm g{(const bf16*)ACT8, (const bf16*)WD8, M, D, FF}; pg8::SplitOrder S; S.init(M, D, FF / 128, G, bx, NSL_D1); pg8::EpiResid8<true> E{HB1, D, 0.5f, (float*)ST, x, meta, nullptr, LP, NPAD, SEQ, ROWMAXD1, COLMAXD1, SQ1, M};
        pg8::gemm_phase<pg8::EpiResid8<true>, pg8::SplitOrder, true, true, true>(lds, g, S, E);
        { constexpr int I_GU = (D / 64) * (NGU / 32), I_TAIL = (int)(I_GU * P2_TAIL_FRAC); const int nbusy = (G > 4 * (D / 256) * NSL_D1) ? (D / 256) * NSL_D1 : 0;
          if (bx >= nbusy) for (int it = (bx - nbusy) * NWAVES + wave; it < I_TAIL; it += (G - nbusy) * NWAVES) quant_item(w_gu2, D, NGU, WGU8b, scr, it, lane, g_ffn2, COLMAX2); } }
    SEAM(2);
    if (IN(3)) for (int rep = 0; rep < REP[3]; ++rep) {
        stats_phase<true>(x, nullptr, HB1, RSTD, (const float*)ST, red, bx, G, gw, NGW, wave, lane, nullptr, SQ1);
        constexpr int I_GU = (D / 64) * (NGU / 32), I_D = (FF / 64) * (D / 32);
        for (int it = (int)(I_GU * P2_TAIL_FRAC) + gw; it < I_GU; it += NGW) quant_item(w_gu2, D, NGU, WGU8b, scr, it, lane, g_ffn2, COLMAX2);
    }
    SEAM(3);
    if (IN(4)) for (int rep = 0; rep < REP[4]; ++rep) { pg8::Gemm g{HB1, WIN, M, INW, D}; pg8::StaticOrder S; S.init(M, INW, G, bx); pg8::EpiProj E{PROJ, INW, b_in, LP, NPAD, RSTD};
        pg8::gemm_phase<pg8::EpiProj, pg8::StaticOrder, true, true>(lds, g, S, E);
        { const int nunits = (M / 256) * (INW / 256), rounds = (nunits + G - 1) / G, nidle = rounds * G - nunits; int first = G - nidle, nconv = nidle; if (nidle < 8) { first = 0; nconv = G; }
          if (bx >= first) for (int it = (bx - first) * NWAVES + wave; it < (FF / 64) * (D / 32); it += nconv * NWAVES) transpose_item_rot(w_d2, FF, D, WD, scr, it, lane, (unsigned*)COLMAXD2); } }
    SEAM(4);
    if (IN(5)) for (int rep = 0; rep < REP[5]; ++rep) {
#ifndef PROBE_KVREP
#define PROBE_KVREP 1
#endif
#ifndef PROBE_ATREP
#define PROBE_ATREP 1
#endif
        for (int r2 = 0; r2 < PROBE_KVREP; ++r2)
        kv_phase(lds, PROJ, ST, bx, G, tid, wave, lane);
        __syncthreads();
        for (int r2 = 0; r2 < PROBE_ATREP; ++r2)
        for (int u = bx; u < 512; u += G) {   int n, b, g; if (u < 512) { n = 1 + (u >> 3); b = (u >> 2) & 1; g = u & 3; } else { n = 0; b = (u - 512) >> 2; g = u & 3; }
            attn_unit(lds, PROJ, MG, sinks, b, n, g, tid, wave, lane); }
    }
    SEAM(5);
    if (IN(6)) scan_phase(ST, vcu * (NWAVES * 64) + tid, G * NWAVES * 64);
    SEAM(6);
    if (IN(7)) for (int rep = 0; rep < REP[7]; ++rep) {
        for (int u = bx; u < 1024; u += G) { int n, bh; if (u < 1024) { n = 1 + (u >> 4); bh = u & 15; } else { n = 0; bh = u - 1024; }
            ret_unit(lds, PROJ, ST, MG, bh >> 3, bh & 7, n, tid, wave, lane); }
    }
    SEAM(7);
    if (IN(8)) for (int rep = 0; rep < REP[8]; ++rep) { pg8::Gemm g{MG, WOUT, M, D, D}; pg8::StaticOrder S; S.init(NB * SEQ, D, G, bx, 128, 32); pg8::EpiResid<false> E{HB2, D, 1.0f, nullptr, nullptr, nullptr, HB1, LP, NPAD, SEQ};
        pg8::gemm_phase<pg8::EpiResid<false>, pg8::StaticOrder, true, true>(lds, g, S, E); }
    SEAM(8);
    if (IN(9)) for (int rep = 0; rep < REP[9]; ++rep) { stats_phase<false, true>(nullptr, HB1, HB2, ROWFAC, nullptr, red, bx, G, gw, NGW, wave, lane, XN8); }
    SEAM(9);
    if (IN(10)) for (int rep = 0; rep < REP[10]; ++rep) { pg8::Gemm g{(const bf16*)XN8, (const bf16*)WGU8b, M, NGU, D}; pg8::StaticOrder S; S.init(NB * SEQ, NGU, G, bx, 128, 32); pg8::EpiSwiGLU8 E{ACT, FF, ROWFAC, COLMAX2};
        pg8::gemm_phase<pg8::EpiSwiGLU8, pg8::StaticOrder, true, true, true>(lds, g, S, E);
        { const int nunits = (NB * SEQ / 256) * (NGU / 256), rounds = (nunits + G - 1) / G, nidle = rounds * G - nunits;
          if (nidle >= 8) { if (bx >= G - nidle) rows_to_int8(WD, WD8, (const unsigned*)COLMAXD2, D, FF, (bx - (G - nidle)) * NWAVES + wave, nidle * NWAVES, lane); }
          else rows_to_int8(WD, WD8, (const unsigned*)COLMAXD2, D, FF, gw, NGW, lane); }
        xcd_barrier(bar);
        act_rot_quant<true>(ACT, ACT8, ROWMAXD2, gw, NGW, lane); }
    SEAM(10);
    if (IN(11)) for (int rep = 0; rep < REP[11]; ++rep) { pg8::Gemm g{(const bf16*)ACT8, (const bf16*)WD8, M, D, FF}; pg8::StaticOrder S; S.init(NB * SEQ, D, G, bx, 128, 32); pg8::EpiResid8<false> E{HB3, D, 0.5f, nullptr, nullptr, nullptr, HB2, LP, NPAD, SEQ, ROWMAXD2, COLMAXD2, nullptr, 0};
        pg8::gemm_phase<pg8::EpiResid8<false>, pg8::StaticOrder, true, true, true>(lds, g, S, E); }
    SEAM(11);
    if (IN(12)) for (int rep = 0; rep < REP[12]; ++rep) final_phase(HB2, HB3, args.out, g_fin, nullptr, red, bx, G, gw, NGW, wave, lane);
#undef IN
#undef SEAM
}

extern "C" void kernel_launch(void* const* d_in, const int* in_sizes, int n_in, void* d_out, int out_size, void* d_ws, size_t ws_size, hipStream_t stream) {
    static int grid = 0;
    if (grid == 0) {
        if (n_in != 14 || ws_size < WS_END) { fprintf(stderr, "kernel_launch: expected 14 inputs and >= %zu bytes of workspace, got %d / %zu\n", (size_t)WS_END, n_in, ws_size); grid = -1; return; }
        int dev = 0, cus = 0, per_cu = 0;
        if (hipGetDevice(&dev) != hipSuccess || hipDeviceGetAttribute(&cus, hipDeviceAttributeMultiprocessorCount, dev) != hipSuccess) { grid = -1; return; }
        if (hipFuncSetAttribute((const void*)hybrid_fwd, hipFuncAttributeMaxDynamicSharedMemorySize, LDS_BYTES) != hipSuccess) { fprintf(stderr, "kernel_launch: hipFuncSetAttribute failed\n"); grid = -1; return; }
        if (hipOccupancyMaxActiveBlocksPerMultiprocessor(&per_cu, (const void*)hybrid_fwd, NWAVES * 64, LDS_BYTES) != hipSuccess || per_cu < 1) fprintf(stderr, "kernel_launch: occupancy query reports %d blocks per CU\n", per_cu);
        (void)hipGetLastError();
        grid = cus;
    }
    if (grid < 0) return;
    (void)hipMemsetAsync((char*)d_ws + WS_CTL, 0, CTL_ZERO_BYTES, stream);
    Args a{};
    for (int i = 0; i < 14; ++i) a.in[i] = (const float*)d_in[i];
    a.out = (float*)d_out; a.ws = (unsigned char*)d_ws;
#if MK_PER_PHASE
    for (int p = 0; p < N_PHASES; ++p) { a.ph_lo = p; a.ph_hi = p + 1; hipLaunchKernelGGL(hybrid_fwd, dim3(grid), dim3(NWAVES * 64), LDS_BYTES, stream, a); }
#else
    a.ph_lo = 0; a.ph_hi = N_PHASES; hipLaunchKernelGGL(hybrid_fwd, dim3(grid), dim3(NWAVES * 64), LDS_BYTES, stream, a);
#endif
}
```

```cpp
#include <hip/hip_runtime.h>
#include <cstdio>
#include <cstdint>
#define MK_PER_PHASE 0
namespace pg8 {
#define PG8_LAS __attribute__((address_space(3)))
typedef unsigned short bf16_t;
typedef short bf16x8 __attribute__((ext_vector_type(8)));
typedef float f32x4 __attribute__((ext_vector_type(4)));
typedef unsigned u32x4 __attribute__((ext_vector_type(4)));
typedef int i32x4 __attribute__((ext_vector_type(4)));
template <bool I8> struct AccSel { typedef f32x4 type; }; template <> struct AccSel<true> { typedef i32x4 type; };
constexpr int BM = 256, BK = 64, HALF = 128, HTB = HALF * BK * 2  , STAGE_BYTES = 8 * HTB, NXCD = 8, WGM = 8;

__host__ __device__ __forceinline__ int lds_byte(int r, int c) { const int st = (r >> 4) * 2 + (c >> 5), rr = r & 15, cc = c & 31, ob = rr * 64 + cc * 2; return st * 1024 + (ob ^ (((ob >> 9) & 1) << 5)); }
__host__ __device__ __forceinline__ void stage_rc(int b, int& R, int& C) { const int st = b / 1024, sb = b % 1024, swz = sb ^ (((sb >> 9) & 1) << 5); R = (st >> 1) * 16 + swz / 64; C = (st & 1) * 32 + (swz % 64) / 2; }
__host__ __device__ __forceinline__ int perm32(int rho) { const int n = rho >> 4, i = rho & 15; return 8 * (i >> 2) + 4 * n + (i & 3); }

struct Unit { int pm, pn, kt0, nkt, split, sl, r0; };
struct Gemm { const bf16_t* A; const bf16_t* Bt; int M, N, K; };

struct StaticOrder {
    int nM, nN, nwg, G, c, skip, grp;
    __host__ __device__ void init(int M, int N, int G_, int c_, int skip_ = 0, int grp_ = 1) { nM = M / BM; nN = N / BM; nwg = nM * nN; G = G_; c = c_; skip = skip_; grp = grp_; }
    __host__ __device__ bool next(int i, Unit& u) const {
        const long L = (long)i * G + c; if (L >= nwg) return false;
        int wgid = (int)L; { const int q = nwg / NXCD, r = nwg % NXCD, xcd = wgid % NXCD, off = wgid / NXCD; wgid = (xcd < r ? xcd * (q + 1) : r * (q + 1) + (xcd - r) * q) + off; }
        const int nig = WGM * nN, gid = wgid / nig, fm = gid * WGM, gsz = (nM - fm) < WGM ? (nM - fm) : WGM;
        u.pm = fm + ((wgid % nig) % gsz); u.pn = (wgid % nig) / gsz; u.r0 = u.pm * BM + (skip ? skip * (1 + u.pm / grp) : 0); return true;
    }
    __device__ __forceinline__ void a_ready(const Unit&) const {}
    __device__ __forceinline__ void done(const Unit&) const {}
};
struct SplitOrder {
    StaticOrder base; int G, c, nN, SL, ntp, pm_last;
    __host__ __device__ void init(int M, int N, int ntiles, int G_, int c_, int SL_) { base.init(M - BM, N, G_, c_); G = G_; c = c_; nN = N / BM; SL = SL_; ntp = ntiles / 2; pm_last = M / BM - 1; }
    __host__ __device__ bool next(int i, Unit& u) const {
        if (base.next(i, u)) return true;
        const long L = (long)i * G + c - base.nwg; if (L < 0 || L >= (long)nN * SL) return false;
        const int s = (int)(L / nN); u.pm = pm_last; u.pn = (int)(L % nN); u.r0 = pm_last * BM;
        const int p0 = (ntp * s) / SL, p1 = (ntp * (s + 1)) / SL; u.kt0 = 2 * p0; u.nkt = 2 * (p1 - p0); u.split = 1; u.sl = s; return u.nkt > 0;
    }
    __device__ __forceinline__ void a_ready(const Unit&) const {}
    __device__ __forceinline__ void done(const Unit&) const {}
};
__device__ __forceinline__ unsigned cvt_pk_bf16(float lo, float hi) { unsigned r; asm volatile("v_cvt_pk_bf16_f32 %0, %1, %2" : "=v"(r) : "v"(lo), "v"(hi)); return r; }
__device__ __forceinline__ float silu_f(float g) { return g * __builtin_amdgcn_rcpf(1.0f + __builtin_amdgcn_exp2f(-1.4426950408889634f * g)); }
template <bool HAS_RS> struct EpiSwiGLU {
    static constexpr bool PERM = true, AFTER_DRAIN = false;
    bf16_t* O; int ldc; const float* rstd;
    __device__ __forceinline__ void operator()(const f32x4 (&acc)[2][2][4][2], const Unit& u, int wr, int wc, int fr, int fq) const {
        const int row0 = u.r0 + wr * 64 + fr, col0 = u.pn * HALF + wc * 32 + 8 * fq;
        float rsv[2][4];
#pragma unroll
        for (int ai = 0; ai < 2; ++ai)
#pragma unroll
            for (int m = 0; m < 4; ++m) rsv[ai][m] = HAS_RS ? rstd[row0 + ai * HALF + m * 16] : 1.0f;
#pragma unroll
        for (int ai = 0; ai < 2; ++ai)
#pragma unroll
            for (int m = 0; m < 4; ++m) { bf16_t* rowp = O + (size_t)(row0 + ai * HALF + m * 16) * ldc + col0; const float rs = rsv[ai][m];
                const f32x4 g0 = acc[ai][0][m][0] * rs, g1 = acc[ai][0][m][1] * rs, u0 = acc[ai][1][m][0] * rs, u1 = acc[ai][1][m][1] * rs;
                float a[8];
#pragma unroll
                for (int j = 0; j < 4; ++j) { a[j] = silu_f(g0[j]) * u0[j]; a[4 + j] = silu_f(g1[j]) * u1[j]; }
                u32x4 w; w.x = cvt_pk_bf16(a[0], a[1]); w.y = cvt_pk_bf16(a[2], a[3]); w.z = cvt_pk_bf16(a[4], a[5]); w.w = cvt_pk_bf16(a[6], a[7]);
                *(u32x4*)rowp = w; }
    }
};
struct EpiSwiGLU8 {
    static constexpr bool PERM = true, AFTER_DRAIN = false;
    bf16_t* O; int ldc; const float* rowfac; const float* colmax;
    __device__ __forceinline__ void operator()(const i32x4 (&acc)[2][2][4][2], const Unit& u, int wr, int wc, int fr, int fq) const {
        const int row0 = u.r0 + wr * 64 + fr, col0 = u.pn * HALF + wc * 32 + 8 * fq, brow0 = u.pn * BM + wc * 32 + 8 * fq;
        float rsv[2][4]; f32x4 cg[2], cu[2];
#pragma unroll
        for (int ai = 0; ai < 2; ++ai)
#pragma unroll
            for (int m = 0; m < 4; ++m) rsv[ai][m] = rowfac[row0 + ai * HALF + m * 16];
#pragma unroll
        for (int n = 0; n < 2; ++n) { cg[n] = *(const f32x4*)(colmax + brow0 + 4 * n) * (1.0f / 127.0f); cu[n] = *(const f32x4*)(colmax + brow0 + HALF + 4 * n) * (1.0f / 127.0f); }
#pragma unroll
        for (int ai = 0; ai < 2; ++ai)
#pragma unroll
            for (int m = 0; m < 4; ++m) { bf16_t* rowp = O + (size_t)(row0 + ai * HALF + m * 16) * ldc + col0; const float rs = rsv[ai][m];
                const f32x4 g0 = __builtin_convertvector(acc[ai][0][m][0], f32x4) * cg[0] * rs, g1 = __builtin_convertvector(acc[ai][0][m][1], f32x4) * cg[1] * rs;
                const f32x4 u0 = __builtin_convertvector(acc[ai][1][m][0], f32x4) * cu[0] * rs, u1 = __builtin_convertvector(acc[ai][1][m][1], f32x4) * cu[1] * rs;
                float a[8];
#pragma unroll
                for (int j = 0; j < 4; ++j) { a[j] = silu_f(g0[j]) * u0[j]; a[4 + j] = silu_f(g1[j]) * u1[j]; }
                u32x4 w; w.x = cvt_pk_bf16(a[0], a[1]); w.y = cvt_pk_bf16(a[2], a[3]); w.z = cvt_pk_bf16(a[4], a[5]); w.w = cvt_pk_bf16(a[6], a[7]);
                *(u32x4*)rowp = w; }
    }
};
template <bool SRC_X> struct EpiResid {
    static constexpr bool PERM = true, AFTER_DRAIN = false;
    bf16_t* out; int ldc; float scale; float* part; const float* x0; const float* meta0; const bf16_t* src; int lp, npad, seq;
    __device__ __forceinline__ void operator()(const f32x4 (&acc)[2][2][4][2], const Unit& u, int wr, int wc, int fr, int fq) const {
        if (u.split) { store_partial(acc, u, wr, wc, fr, fq); return; }
        const int row0 = u.r0 + wr * 64 + fr, col0 = u.pn * BM + wc * 32 + 8 * fq;
#pragma unroll
        for (int ai = 0; ai < 2; ++ai)
#pragma unroll
            for (int m = 0; m < 4; ++m) { const int row = row0 + ai * HALF + m * 16; const size_t off = (size_t)row * ldc + col0;
                f32x4 h[2][2];
                if constexpr (SRC_X) { const float* srcp = x0; bool zero = false;
                    { const int b = row / lp, p = row - b * lp; if (p < npad) zero = true; else if (p < npad + 16) srcp = meta0 + (size_t)(p - npad) * ldc + col0; else srcp = x0 + ((size_t)b * seq + (size_t)(p - npad - 16)) * ldc + col0; }
#pragma unroll
                    for (int bj = 0; bj < 2; ++bj)
#pragma unroll
                        for (int n = 0; n < 2; ++n) h[bj][n] = zero ? (f32x4){0.f, 0.f, 0.f, 0.f} : *(const f32x4*)(srcp + bj * HALF + 4 * n);
                } else {
#pragma unroll
                    for (int bj = 0; bj < 2; ++bj) { const u32x4 w = *(const u32x4*)(src + off + bj * HALF);
                        h[bj][0] = (f32x4){__uint_as_float(w.x << 16), __uint_as_float(w.x & 0xffff0000u), __uint_as_float(w.y << 16), __uint_as_float(w.y & 0xffff0000u)};
                        h[bj][1] = (f32x4){__uint_as_float(w.z << 16), __uint_as_float(w.z & 0xffff0000u), __uint_as_float(w.w << 16), __uint_as_float(w.w & 0xffff0000u)}; }
                }
#pragma unroll
                for (int bj = 0; bj < 2; ++bj) { const f32x4 a0 = h[bj][0] + acc[ai][bj][m][0] * scale, a1 = h[bj][1] + acc[ai][bj][m][1] * scale;
                    u32x4 w; w.x = cvt_pk_bf16(a0[0], a0[1]); w.y = cvt_pk_bf16(a0[2], a0[3]); w.z = cvt_pk_bf16(a1[0], a1[1]); w.w = cvt_pk_bf16(a1[2], a1[3]);
                    *(u32x4*)(out + off + bj * HALF) = w; }
                asm volatile("" ::: "memory"); }
    }
    __device__ __forceinline__ void store_partial(const f32x4 (&acc)[2][2][4][2], const Unit& u, int wr, int wc, int fr, int fq) const {
        const int row0 = wr * 64 + fr, col0 = u.pn * BM + wc * 32 + 8 * fq; float* base = part + (size_t)u.sl * BM * ldc;
#pragma unroll
        for (int ai = 0; ai < 2; ++ai)
#pragma unroll
            for (int m = 0; m < 4; ++m) { float* rowp = base + (size_t)(row0 + ai * HALF + m * 16) * ldc + col0;
#pragma unroll
                for (int bj = 0; bj < 2; ++bj)
#pragma unroll
                    for (int n = 0; n < 2; ++n) *(f32x4*)(rowp + bj * HALF + 4 * n) = acc[ai][bj][m][n] * scale; }
    }
};
template <bool SRC_X> struct EpiResid8 {
    static constexpr bool PERM = true, AFTER_DRAIN = false;
    bf16_t* out; int ldc; float scale; float* part; const float* x0; const float* meta0; const bf16_t* src; int lp, npad, seq; const unsigned* rowmax; const float* colmax;
    float* sq; int sqld;
    __device__ __forceinline__ void operator()(const i32x4 (&acc)[2][2][4][2], const Unit& u, int wr, int wc, int fr, int fq) const {
        const int row0 = u.r0 + wr * 64 + fr, col0 = u.pn * BM + wc * 32 + 8 * fq;
        f32x4 cf[2][2]; float rf[2][4];
#pragma unroll
        for (int bj = 0; bj < 2; ++bj)
#pragma unroll
            for (int n = 0; n < 2; ++n) cf[bj][n] = *(const f32x4*)(colmax + col0 + bj * HALF + 4 * n) * (scale * (1.0f / (127.0f * 127.0f)));
#pragma unroll
        for (int ai = 0; ai < 2; ++ai)
#pragma unroll
            for (int m = 0; m < 4; ++m) rf[ai][m] = __uint_as_float(rowmax[row0 + ai * HALF + m * 16]);
        if (u.split) {
            const int prow0 = wr * 64 + fr; float* base = part + (size_t)u.sl * BM * ldc;
#pragma unroll
            for (int ai = 0; ai < 2; ++ai)
#pragma unroll
                for (int m = 0; m < 4; ++m) { float* rowp = base + (size_t)(prow0 + ai * HALF + m * 16) * ldc + col0;
#pragma unroll
                    for (int bj = 0; bj < 2; ++bj)
#pragma unroll
                        for (int n = 0; n < 2; ++n) *(f32x4*)(rowp + bj * HALF + 4 * n) = __builtin_convertvector(acc[ai][bj][m][n], f32x4) * cf[bj][n] * rf[ai][m]; }
            return; }
#pragma unroll
        for (int ai = 0; ai < 2; ++ai)
#pragma unroll
            for (int m = 0; m < 4; ++m) { const int row = row0 + ai * HALF + m * 16; const size_t off = (size_t)row * ldc + col0;
                f32x4 h[2][2];
                if constexpr (SRC_X) { const float* srcp = x0; bool zero = false;
                    { const int b = row / lp, p = row - b * lp; if (p < npad) zero = true; else if (p < npad + 16) srcp = meta0 + (size_t)(p - npad) * ldc + col0; else srcp = x0 + ((size_t)b * seq + (size_t)(p - npad - 16)) * ldc + col0; }
#pragma unroll
                    for (int bj = 0; bj < 2; ++bj)
#pragma unroll
                        for (int n = 0; n < 2; ++n) h[bj][n] = zero ? (f32x4){0.f, 0.f, 0.f, 0.f} : *(const f32x4*)(srcp + bj * HALF + 4 * n);
                } else {
#pragma unroll
                    for (int bj = 0; bj < 2; ++bj) { const u32x4 w = *(const u32x4*)(src + off + bj * HALF);
                        h[bj][0] = (f32x4){__uint_as_float(w.x << 16), __uint_as_float(w.x & 0xffff0000u), __uint_as_float(w.y << 16), __uint_as_float(w.y & 0xffff0000u)};
                        h[bj][1] = (f32x4){__uint_as_float(w.z << 16), __uint_as_float(w.z & 0xffff0000u), __uint_as_float(w.w << 16), __uint_as_float(w.w & 0xffff0000u)}; }
                }
                float ss = 0.f;
#pragma unroll
                for (int bj = 0; bj < 2; ++bj) { const f32x4 a0 = h[bj][0] + __builtin_convertvector(acc[ai][bj][m][0], f32x4) * cf[bj][0] * rf[ai][m], a1 = h[bj][1] + __builtin_convertvector(acc[ai][bj][m][1], f32x4) * cf[bj][1] * rf[ai][m];
                    u32x4 w; w.x = cvt_pk_bf16(a0[0], a0[1]); w.y = cvt_pk_bf16(a0[2], a0[3]); w.z = cvt_pk_bf16(a1[0], a1[1]); w.w = cvt_pk_bf16(a1[2], a1[3]);
                    *(u32x4*)(out + off + bj * HALF) = w;
                    if (sq) ss += ((a0[0] * a0[0] + a0[1] * a0[1]) + (a0[2] * a0[2] + a0[3] * a0[3])) + ((a1[0] * a1[0] + a1[1] * a1[1]) + (a1[2] * a1[2] + a1[3] * a1[3])); }
                if (sq) { ss += __shfl_xor(ss, 16); ss += __shfl_xor(ss, 32); if (fq == 0) sq[(size_t)(4 * u.pn + wc) * sqld + row] = ss; }
                asm volatile("" ::: "memory"); }
    }
};
struct EpiProj {
    static constexpr bool PERM = true, AFTER_DRAIN = false;
    bf16_t* O; int ldc; const float* bias; int lp, npad; const float* rstd;
    __device__ __forceinline__ void operator()(const f32x4 (&acc)[2][2][4][2], const Unit& u, int wr, int wc, int fr, int fq) const {
        const int row0 = u.r0 + wr * 64 + fr, col0 = u.pn * BM + wc * 32 + 8 * fq;
        f32x4 bv[2][2];
#pragma unroll
        for (int bj = 0; bj < 2; ++bj)
#pragma unroll
            for (int n = 0; n < 2; ++n) bv[bj][n] = *(const f32x4*)(bias + col0 + bj * HALF + 4 * n);
        float rsv[2][4];
#pragma unroll
        for (int ai = 0; ai < 2; ++ai)
#pragma unroll
            for (int m = 0; m < 4; ++m) rsv[ai][m] = rstd[row0 + ai * HALF + m * 16];
#pragma unroll
        for (int ai = 0; ai < 2; ++ai)
#pragma unroll
            for (int m = 0; m < 4; ++m) { const int row = row0 + ai * HALF + m * 16; bf16_t* rowp = O + (size_t)row * ldc + col0;
                const bool pad = (row % lp) < npad; const float rs = rsv[ai][m];
#pragma unroll
                for (int bj = 0; bj < 2; ++bj) { const f32x4 v0 = acc[ai][bj][m][0] * rs + bv[bj][0], v1 = acc[ai][bj][m][1] * rs + bv[bj][1];
                    u32x4 w; w.x = cvt_pk_bf16(v0[0], v0[1]); w.y = cvt_pk_bf16(v0[2], v0[3]); w.z = cvt_pk_bf16(v1[0], v1[1]); w.w = cvt_pk_bf16(v1[2], v1[3]);
                    if (pad) w = (u32x4){0u, 0u, 0u, 0u};
                    *(u32x4*)(rowp + bj * HALF) = w; } }
    }
};
template <bool I8> __device__ __forceinline__ typename AccSel<I8>::type mma16(bf16x8 a, bf16x8 b, typename AccSel<I8>::type c) {
    if constexpr (I8) return __builtin_amdgcn_mfma_i32_16x16x64_i8(__builtin_bit_cast(i32x4, a), __builtin_bit_cast(i32x4, b), c, 0, 0, 0);
    else return __builtin_amdgcn_mfma_f32_16x16x32_bf16(a, b, c, 0, 0, 0);
}
template <class Epi, class Sched, bool ALIGN_EPI = false, bool SP2 = false, bool I8 = false>
__device__ __forceinline__ void gemm_phase(PG8_LAS unsigned char* lds, const Gemm g, const Sched& S, const Epi& E) {
    const int tid = threadIdx.x, wid = __builtin_amdgcn_readfirstlane(tid >> 6), lane = tid & 63, wr = wid >> 2, wc = wid & 3, fr = lane & 15, fq = lane >> 4;
    const int K = g.K, RB = I8 ? K : 2 * K  , nt = RB / (2 * BK);
    unsigned voffA[2], voffB[2];
#pragma unroll
    for (int i = 0; i < 2; ++i) { int R, C; stage_rc(tid * 16 + i * 8192, R, C); const int Rb = Epi::PERM ? ((R & ~31) + perm32(R & 31)) : R;
        voffA[i] = (unsigned)(R * RB + 2 * C); voffB[i] = (unsigned)(Rb * RB + 2 * C); }
    const size_t kstep = (size_t)(BK * 2);
    const size_t hstep = (size_t)HALF * RB;
    const size_t tstep = 2 * hstep;
    const unsigned ldsw = (unsigned)wid * 1024u;
    const int aoff = lds_byte(wr * 64 + fr, fq * 8), boff = lds_byte(wc * 32 + fr, fq * 8);
#define PG8_SA(b, h) (((b) * 2 + (h)) * HTB)
#define PG8_SB(b, h) ((4 + (b) * 2 + (h)) * HTB)
#define PG8_STAGE(bufoff, gbase, voff) do { _Pragma("unroll") for (int _i = 0; _i < 2; ++_i) \
        __builtin_amdgcn_global_load_lds((const unsigned*)((const char*)(gbase) + (voff)[_i]), (PG8_LAS unsigned*)(lds + (bufoff) + ldsw + _i * 8192), 16, 0, 0); } while (0)
#define PG8_LDA(dst, b, h) do { _Pragma("unroll") for (int m = 0; m < 4; ++m) _Pragma("unroll") for (int k = 0; k < 2; ++k) dst[m][k] = *(const PG8_LAS bf16x8*)(lds + PG8_SA(b, h) + aoff + m * 2048 + k * 1024); } while (0)
#define PG8_LDB(dst, b, h) do { _Pragma("unroll") for (int n = 0; n < 2; ++n) _Pragma("unroll") for (int k = 0; k < 2; ++k) dst[n][k] = *(const PG8_LAS bf16x8*)(lds + PG8_SB(b, h) + boff + n * 2048 + k * 1024); } while (0)
#define PG8_MMA(ai, bj, At, Bt) do { __builtin_amdgcn_s_setprio(1); asm volatile(".p2align 3"); _Pragma("unroll") for (int m = 0; m < 4; ++m) _Pragma("unroll") for (int n = 0; n < 2; ++n) _Pragma("unroll") for (int k = 0; k < 2; ++k) \
        acc[ai][bj][m][n] = mma16<I8>(Bt[n][k], At[m][k], acc[ai][bj][m][n]); __builtin_amdgcn_s_setprio(0); } while (0)
#define PG8_WAIT_V(n) asm volatile("s_waitcnt vmcnt(" #n ")" ::: "memory")
#define PG8_WAIT_L(n) asm volatile("s_waitcnt lgkmcnt(" #n ")" ::: "memory")
#define PG8_BAR __builtin_amdgcn_s_barrier()
#define PG8_SCHED __builtin_amdgcn_sched_barrier(0)
    Unit cur, nxt; int ui = 0;
    cur.kt0 = 0; cur.nkt = nt; cur.split = 0; cur.sl = 0;
    if (!S.next(0, cur)) return;
    typedef typename AccSel<I8>::type acc_t; const acc_t acc_zero = {};
    acc_t acc[2][2][4][2];
#pragma unroll
    for (int a = 0; a < 2; ++a)
#pragma unroll
        for (int b = 0; b < 2; ++b)
#pragma unroll
            for (int m = 0; m < 4; ++m)
#pragma unroll
                for (int n = 0; n < 2; ++n) acc[a][b][m][n] = acc_zero;
    bf16x8 At[4][2], B0[2][2], B1[2][2];
    const char* cA = (const char*)g.A + (size_t)cur.r0 * RB + (size_t)cur.kt0 * kstep; const char* cB = (const char*)g.Bt + (size_t)cur.pn * tstep + (size_t)cur.kt0 * kstep;
    S.a_ready(cur);
    if constexpr (SP2) {
        PG8_STAGE(PG8_SB(0, 0), cB, voffB); PG8_STAGE(PG8_SB(0, 1), cB + hstep, voffB); PG8_STAGE(PG8_SA(0, 0), cA, voffA); PG8_STAGE(PG8_SA(0, 1), cA + hstep, voffA);
        if (wr == 1) PG8_BAR;
        PG8_WAIT_V(2); PG8_BAR;
        PG8_STAGE(PG8_SB(1, 0), cB + kstep, voffB); PG8_STAGE(PG8_SA(1, 0), cA + kstep, voffA); PG8_STAGE(PG8_SB(1, 1), cB + hstep + kstep, voffB);
        PG8_WAIT_V(6); PG8_BAR;
    } else {
        PG8_STAGE(PG8_SB(0, 0), cB, voffB); PG8_STAGE(PG8_SA(0, 0), cA, voffA); PG8_STAGE(PG8_SB(0, 1), cB + hstep, voffB); PG8_STAGE(PG8_SA(0, 1), cA + hstep, voffA);
        if (wr == 1) PG8_BAR;
        PG8_WAIT_V(4); PG8_BAR;
        PG8_STAGE(PG8_SB(1, 0), cB + kstep, voffB); PG8_STAGE(PG8_SA(1, 0), cA + kstep, voffA); PG8_STAGE(PG8_SB(1, 1), cB + hstep + kstep, voffB);
        PG8_WAIT_V(6); PG8_BAR;
    }
    for (;;) {
        nxt.kt0 = 0; nxt.nkt = nt; nxt.split = 0; nxt.sl = 0;
        const bool has_next = S.next(ui + 1, nxt);
        const int cnt = cur.nkt;
        const char* nA = has_next ? (const char*)g.A + (size_t)nxt.r0 * RB + (size_t)nxt.kt0 * kstep : cA; const char* nB = has_next ? (const char*)g.Bt + (size_t)nxt.pn * tstep + (size_t)nxt.kt0 * kstep : cB;
        asm volatile(".p2align 6");
        for (int t = 0; t < cnt; t += 2) {
            const bool last = (t == cnt - 2);
            const char* a1 = cA + (size_t)(t + 1) * kstep;
            const char* a2 = last ? nA : cA + (size_t)(t + 2) * kstep; const char* b2 = last ? nB : cB + (size_t)(t + 2) * kstep;
            const char* a3 = a2 + kstep; const char* b3 = b2 + kstep;
            if (last && has_next) S.a_ready(nxt);
            if constexpr (SP2) {
            PG8_LDB(B0, 0, 0); PG8_LDB(B1, 0, 1); PG8_SCHED; PG8_LDA(At, 0, 0); PG8_STAGE(PG8_SA(1, 1), a1 + hstep, voffA);
            PG8_WAIT_V(8); PG8_WAIT_L(0); PG8_BAR; PG8_MMA(0, 0, At, B0); PG8_MMA(0, 1, At, B1); PG8_BAR; PG8_SCHED;
            PG8_LDA(At, 0, 1); PG8_STAGE(PG8_SB(0, 0), b2, voffB); PG8_STAGE(PG8_SB(0, 1), b2 + hstep, voffB); PG8_STAGE(PG8_SA(0, 0), a2, voffA);
            PG8_WAIT_V(8); PG8_WAIT_L(0); PG8_BAR; PG8_MMA(1, 0, At, B0); PG8_MMA(1, 1, At, B1); PG8_BAR; PG8_SCHED;
            PG8_LDB(B0, 1, 0); PG8_LDB(B1, 1, 1); PG8_SCHED; PG8_LDA(At, 1, 0); PG8_STAGE(PG8_SA(0, 1), a2 + hstep, voffA);
            PG8_WAIT_V(8); PG8_WAIT_L(0); PG8_BAR; PG8_MMA(0, 0, At, B0); PG8_MMA(0, 1, At, B1); PG8_BAR; PG8_SCHED;
            PG8_LDA(At, 1, 1); PG8_STAGE(PG8_SB(1, 0), b3, voffB); PG8_STAGE(PG8_SB(1, 1), b3 + hstep, voffB); PG8_STAGE(PG8_SA(1, 0), a3, voffA);
            PG8_WAIT_V(8); PG8_WAIT_L(0); PG8_BAR; PG8_MMA(1, 0, At, B0); PG8_MMA(1, 1, At, B1); PG8_BAR; PG8_SCHED;
            } else {
            PG8_LDB(B0, 0, 0); PG8_SCHED; PG8_LDA(At, 0, 0); PG8_STAGE(PG8_SA(1, 1), a1 + hstep, voffA);
            PG8_WAIT_L(8); PG8_BAR; PG8_WAIT_L(0); PG8_MMA(0, 0, At, B0); PG8_BAR; PG8_SCHED;
            PG8_LDB(B1, 0, 1); PG8_STAGE(PG8_SB(0, 0), b2, voffB);
            PG8_BAR; PG8_WAIT_L(0); PG8_MMA(0, 1, At, B1); PG8_BAR;
            PG8_LDA(At, 0, 1); PG8_STAGE(PG8_SA(0, 0), a2, voffA);
            PG8_BAR; PG8_WAIT_L(0); PG8_MMA(1, 0, At, B0); PG8_BAR; PG8_SCHED;
            PG8_STAGE(PG8_SB(0, 1), b2 + hstep, voffB);
            PG8_WAIT_V(6); PG8_BAR; PG8_MMA(1, 1, At, B1); PG8_BAR;
            PG8_LDB(B0, 1, 0); PG8_SCHED; PG8_LDA(At, 1, 0); PG8_STAGE(PG8_SA(0, 1), a2 + hstep, voffA);
            PG8_WAIT_L(8); PG8_BAR; PG8_WAIT_L(0); PG8_MMA(0, 0, At, B0); PG8_BAR; PG8_SCHED;
            PG8_LDB(B1, 1, 1); PG8_STAGE(PG8_SB(1, 0), b3, voffB);
            PG8_BAR; PG8_WAIT_L(0); PG8_MMA(0, 1, At, B1); PG8_BAR;
            PG8_LDA(At, 1, 1); PG8_STAGE(PG8_SA(1, 0), a3, voffA);
            PG8_BAR; PG8_WAIT_L(0); PG8_MMA(1, 0, At, B0); PG8_BAR; PG8_SCHED;
            PG8_STAGE(PG8_SB(1, 1), b3 + hstep, voffB);
            PG8_WAIT_V(6); PG8_BAR; PG8_MMA(1, 1, At, B1); PG8_BAR;
            }
        }
        if constexpr (ALIGN_EPI) { if (wr == 0) PG8_BAR; }
        if constexpr (!Epi::AFTER_DRAIN) { E(acc, cur, wr, wc, fr, fq); S.done(cur); }
        if (!has_next) break;
#pragma unroll
        for (int a = 0; a < 2; ++a)
#pragma unroll
            for (int b = 0; b < 2; ++b)
#pragma unroll
                for (int m = 0; m < 4; ++m)
#pragma unroll
                    for (int n = 0; n < 2; ++n) acc[a][b][m][n] = acc_zero;
        cur = nxt; cA = nA; cB = nB; ++ui;
        if constexpr (ALIGN_EPI) { if (wr == 1) PG8_BAR; }
    }
    PG8_WAIT_V(0);
    if constexpr (!ALIGN_EPI) { if (wr == 0) PG8_BAR; }
    PG8_BAR;
    if constexpr (Epi::AFTER_DRAIN) { E.fused(acc, cur, wr, wc, fr, fq, lds, wid, lane); S.done(cur); }
#undef PG8_SA
#undef PG8_SB
#undef PG8_STAGE
#undef PG8_LDA
#undef PG8_LDB
#undef PG8_MMA
#undef PG8_WAIT_V
#undef PG8_WAIT_L
#undef PG8_BAR
#undef PG8_SCHED
}
}
#ifndef MK_PER_PHASE
#define MK_PER_PHASE 0
#endif
constexpr int NWAVES = 8;
constexpr int D = 4096, SEQ = 8192, NB = 2, LP = 8320, NCH = 65, NPAD = 112, M = NB * LP;
constexpr int FF = 11008, NGU = 2 * FF, INW = 10752;
constexpr int OFF_QA = 0, OFF_KA = 2048, OFF_VA = 2304, OFF_QR = 2560, OFF_KR = 4608, OFF_VR = 6656, OFF_GR = 8704;
constexpr float EPS = 1e-6f, LOG2E = 1.4426950408889634f;
static_assert(M % 256 == 0 && NGU % 256 == 0 && INW % 256 == 0 && FF % 128 == 0, "GEMM tiling");

constexpr size_t MiB = 1u << 20;
constexpr size_t WS_CTL = 0, CTL_ZERO_BYTES = 1 * MiB;
constexpr size_t WS_H = 1 * MiB;
constexpr size_t WS_XN = 261 * MiB;
constexpr size_t WS_ACT = 563 * MiB;
constexpr size_t WS_WGU = 391 * MiB;
constexpr size_t WS_WD = 913 * MiB;
constexpr size_t WS_WIN = 999 * MiB;
constexpr size_t WS_WOUT = 1083 * MiB;
constexpr size_t WS_ST = 1115 * MiB;
constexpr size_t WS_HB2 = 1245 * MiB;
constexpr size_t WS_WD8 = 1375 * MiB;
constexpr size_t WS_END = 1418 * MiB;
constexpr size_t WS_RSTD = 512 * 1024;
constexpr size_t WS_ROWFAC = 580 * 1024;
constexpr size_t WS_ROWMAXD1 = 824 * 1024, WS_ROWMAXD2 = 890 * 1024, WS_COLMAXD1 = 956 * 1024, WS_COLMAXD2 = 972 * 1024;
constexpr size_t WS_COLMAX1 = 648 * 1024, WS_COLMAX2 = 736 * 1024;
constexpr int CW_BAR = 4096;
static_assert(WS_ROWFAC >= WS_RSTD + (size_t)M * 4 && WS_COLMAX1 >= WS_ROWFAC + (size_t)M * 4 && WS_COLMAX2 >= WS_COLMAX1 + (size_t)NGU * 4 && WS_COLMAX2 + (size_t)NGU * 4 <= CTL_ZERO_BYTES, "control region map");


constexpr int SCR_BYTES = 143360;
constexpr int MISC_OFF = SCR_BYTES;
constexpr int LDS_BYTES = 147456;

#define GAS __attribute__((address_space(1)))
#define LAS __attribute__((address_space(3)))
typedef unsigned short bf16;
typedef unsigned v4u __attribute__((ext_vector_type(4)));
typedef unsigned v2u __attribute__((ext_vector_type(2)));
typedef float f32x4 __attribute__((ext_vector_type(4)));
typedef short bf16x8 __attribute__((ext_vector_type(8)));
typedef short s16x4 __attribute__((ext_vector_type(4)));
#define LDS_WAIT() asm volatile("s_waitcnt lgkmcnt(0)" ::: "memory")
#define MFMA16(a, b, c) __builtin_amdgcn_mfma_f32_16x16x32_bf16((a), (b), (c), 0, 0, 0)
__device__ __forceinline__ float bf2f(unsigned b16) { return __uint_as_float(b16 << 16); }
typedef float f32x2_t __attribute__((ext_vector_type(2))); typedef __bf16 bf16x2_t __attribute__((ext_vector_type(2)));
__device__ __forceinline__ unsigned pk2(float lo, float hi) { const f32x2_t v = {lo, hi}; return __builtin_bit_cast(unsigned, __builtin_convertvector(v, bf16x2_t)); }
__device__ __forceinline__ float wave_sum(float v) {
#pragma unroll
    for (int o = 1; o < 64; o <<= 1) v += __shfl_xor(v, o);
    return v;
}
__device__ __forceinline__ s16x4 ds_tr16(const LAS unsigned char* p) { return __builtin_bit_cast(s16x4, __builtin_amdgcn_ds_read_tr16_b64_v4i16((LAS s16x4*)p)); }
__device__ __forceinline__ bf16x8 cat8(s16x4 lo, s16x4 hi) { return (bf16x8){lo[0], lo[1], lo[2], lo[3], hi[0], hi[1], hi[2], hi[3]}; }
__device__ __forceinline__ float log2_gamma(int h) { return log1pf(-exp2f(-5.0f - (float)h)) * LOG2E; }

#define XB_TMO      128
#define XB_XCNT(j)  (256  + 64 * (j))
#define XB_XSUB(j)  (1280 + 64 * (j))
#define XB_XGEN(j)  (2304 + 64 * (j))
#define XB_TOP      3328
#define XB_TOPGEN   3392
#define XCD_BAR_WORDS 3456
#define XB_SPIN_CAP (1u << 18)

__device__ __forceinline__ unsigned xb_ld(unsigned* p)              { return __hip_atomic_load(p, __ATOMIC_RELAXED, __HIP_MEMORY_SCOPE_AGENT); }
__device__ __forceinline__ unsigned xb_add(unsigned* p, unsigned v) { return __hip_atomic_fetch_add(p, v, __ATOMIC_RELAXED, __HIP_MEMORY_SCOPE_AGENT); }
__device__ __forceinline__ unsigned xb_xcc_id() { return (unsigned)__builtin_amdgcn_s_getreg((3 << 11) | 20) & 0xFu; }
#define XB_SPIN(cond, bar) do { unsigned _sp = 0; while (cond) { __builtin_amdgcn_s_sleep(1); \
    if ((++_sp & 255u) == 0u) { if (xb_ld(&(bar)[XB_TMO])) break; if (_sp > XB_SPIN_CAP) { atomicAdd(&(bar)[XB_TMO], 1u); break; } } } } while (0)

struct XcdBarrier {
    unsigned* bar; unsigned x;
    volatile LAS unsigned* st;
};

__device__ __forceinline__ XcdBarrier xcd_barrier_post(unsigned* bar, volatile LAS unsigned* st) {
    XcdBarrier b; b.bar = bar; b.x = xb_xcc_id(); b.st = st;
    if (threadIdx.x == 0) (void)xb_add(&bar[XB_XCNT(b.x)], 1u);
    return b;
}
__device__ __forceinline__ void xcd_barrier_complete(unsigned* bar, unsigned x, unsigned& nloc, unsigned& nx) {
    const unsigned G = gridDim.x * gridDim.y * gridDim.z;
    unsigned sum, cnt, mine, sp = 0u;
    for (;;) {
        sum = 0u; cnt = 0u; mine = 0u;
#pragma unroll
        for (unsigned j = 0; j < 16; ++j) { const unsigned c = xb_ld(&bar[XB_XCNT(j)]); sum += c; cnt += (c > 0u) ? 1u : 0u; mine = (j == x) ? c : mine; }
        if (sum == G) break;
        __builtin_amdgcn_s_sleep(1);
        if ((++sp & 255u) == 0u) { if (xb_ld(&bar[XB_TMO])) break; if (sp > XB_SPIN_CAP) { atomicAdd(&bar[XB_TMO], 1u); break; } }
    }
    nloc = mine > 0u ? mine : 1u; nx = cnt > 0u ? cnt : 1u;
}

__device__ __forceinline__ void xcd_barrier(const XcdBarrier& b) {
    asm volatile("s_waitcnt vmcnt(0)" ::: "memory");
    __syncthreads();
    if (threadIdx.x == 0) {
        unsigned* bar = b.bar;
        __builtin_amdgcn_s_waitcnt(0);
        unsigned nloc = b.st[0], nx = b.st[1];
        if (nloc == 0u) { xcd_barrier_complete(bar, b.x, nloc, nx); b.st[0] = nloc; b.st[1] = nx; }
        const unsigned old = xb_add(&bar[XB_XSUB(b.x)], 1u);
        const unsigned gen = old / nloc;
        if (old + 1u == (gen + 1u) * nloc) {
            __builtin_amdgcn_fence(__ATOMIC_RELEASE, "agent");
            asm volatile("s_waitcnt vmcnt(0)" ::: "memory");
            const unsigned og = xb_add(&bar[XB_TOP], 1u);
            const unsigned tg = og / nx;
            if (og + 1u == (tg + 1u) * nx) xb_add(&bar[XB_TOPGEN], 1u);
            else XB_SPIN(xb_ld(&bar[XB_TOPGEN]) == tg, bar);
            __builtin_amdgcn_fence(__ATOMIC_ACQUIRE, "agent");
            xb_add(&bar[XB_XGEN(b.x)], 1u);
            asm volatile("s_waitcnt vmcnt(0)" ::: "memory");
        } else {
            XB_SPIN(xb_ld(&bar[XB_XGEN(b.x)]) == gen, bar);
            __builtin_amdgcn_fence(__ATOMIC_ACQUIRE, "agent");
            asm volatile("s_waitcnt vmcnt(0)" ::: "memory");
        }
    }
    __syncthreads();
}


__device__ __forceinline__ void rows_init(const float* x, const float* meta, bf16* HB, float* rstd, int gw, int NGW, int lane) {
    for (int r = gw; r < M; r += NGW) {
        const int b = r / LP, p = r - b * LP;
        const bool zero = p < NPAD; const float* src = (p < 128) ? meta + (size_t)(zero ? 0 : p - NPAD) * D : x + ((size_t)b * SEQ + (size_t)(p - 128)) * D;
        f32x4 v[16]; float ss = 0.f;
#pragma unroll
        for (int j = 0; j < 16; ++j) { v[j] = zero ? (f32x4){0.f, 0.f, 0.f, 0.f} : ((const f32x4*)src)[lane + 64 * j]; ss += (v[j].x * v[j].x + v[j].y * v[j].y) + (v[j].z * v[j].z + v[j].w * v[j].w); }
        ss = wave_sum(ss);
        const float rs = 1.0f / sqrtf(ss * (1.0f / D) + EPS);
#pragma unroll
        for (int j = 0; j < 16; ++j) { const f32x4 y = v[j] * rs; v2u w; w.x = pk2(y.x, y.y); w.y = pk2(y.z, y.w); ((v2u*)(HB + (size_t)r * D))[lane + 64 * j] = w; }
    }
}
__device__ __forceinline__ f32x4 bf4_to_f32(v2u w) { return (f32x4){__uint_as_float(w.x << 16), __uint_as_float(w.x & 0xffff0000u), __uint_as_float(w.y << 16), __uint_as_float(w.y & 0xffff0000u)}; }
constexpr int NSL_D1 = 3;
constexpr float P2_TAIL_FRAC = 0.85f;
template <bool FROM_X, bool Q8 = false>
__device__ __forceinline__ void stats_phase(const float* x, const bf16* Hprev, bf16* HB, float* rstd, const float* part, LAS float* red, int bx, int G, int gw, int NGW, int wave, int lane, unsigned char* A8 = nullptr, const float* sq = nullptr) {
    if (part) for (int hr = bx; hr < 256; hr += G) {
        const int r = M - 256 + hr, b = r / LP, p = r - b * LP;
        f32x4 v[2]; float ss = 0.f, am = 0.f;
#pragma unroll
        for (int j = 0; j < 2; ++j) { const size_t c = (size_t)(512 * wave + 256 * j + 4 * lane);
            v[j] = FROM_X ? *(const f32x4*)(x + ((size_t)b * SEQ + (size_t)(p - 128)) * D + c) : bf4_to_f32(*(const v2u*)(Hprev + (size_t)r * D + c));
#pragma unroll
            for (int s = 0; s < NSL_D1; ++s) v[j] = v[j] + *(const f32x4*)(part + ((size_t)s * 256 + hr) * D + c);
            { v2u w; w.x = pk2(v[j].x, v[j].y); w.y = pk2(v[j].z, v[j].w); *(v2u*)(HB + (size_t)r * D + c) = w; }
            ss += (v[j].x * v[j].x + v[j].y * v[j].y) + (v[j].z * v[j].z + v[j].w * v[j].w);
            am = fmaxf(fmaxf(am, fmaxf(fabsf(v[j].x), fabsf(v[j].y))), fmaxf(fabsf(v[j].z), fabsf(v[j].w))); }
        ss = wave_sum(ss);
#pragma unroll
        for (int o = 1; o < 64; o <<= 1) am = fmaxf(am, __shfl_xor(am, o));
        if (lane == 0) { red[wave] = ss; red[NWAVES + wave] = am; }
        __syncthreads();
        float tot = 0.f, amt = 0.f;
#pragma unroll
        for (int w = 0; w < NWAVES; ++w) { tot += red[w]; amt = fmaxf(amt, red[NWAVES + w]); }
        __syncthreads();
        const float rs = 1.0f / sqrtf(tot * (1.0f / D) + EPS);
        if (!Q8) { if (wave == 0 && lane == 0) rstd[r] = rs; }
        else { const float inv = amt > 0.f ? 127.0f / amt : 0.f; if (wave == 0 && lane == 0) rstd[r] = rs * amt * (1.0f / 127.0f);
#pragma unroll
            for (int j = 0; j < 2; ++j) { const size_t c = (size_t)(512 * wave + 256 * j + 4 * lane);
                const int b0 = (int)rintf(v[j].x * inv), b1 = (int)rintf(v[j].y * inv), b2 = (int)rintf(v[j].z * inv), b3 = (int)rintf(v[j].w * inv);
                *(unsigned*)(A8 + (size_t)r * D + c) = (unsigned)(b0 & 0xff) | ((unsigned)(b1 & 0xff) << 8) | ((unsigned)(b2 & 0xff) << 16) | ((unsigned)(b3 & 0xff) << 24); } }
    }
    if (!Q8 && sq) {
        for (int r = gw * 64 + lane; r < M - 256; r += NGW * 64) { float s = 0.f;
#pragma unroll 16
            for (int t = 0; t < 64; ++t) s += sq[(size_t)t * M + r];
            rstd[r] = 1.0f / sqrtf(s * (1.0f / D) + EPS); }
        return; }
    for (int r = gw; r < (part ? M - 256 : M); r += NGW) {
        if (!part && (r % LP) < 128) continue;
        float ss = 0.f, am = 0.f; v4u wq[8];
#pragma unroll
        for (int j = 0; j < 8; ++j) { const v4u w = ((const v4u*)(HB + (size_t)r * D))[lane + 64 * j]; wq[j] = w;
            const float a0 = bf2f(w.x & 0xffffu), a1 = bf2f(w.x >> 16), a2 = bf2f(w.y & 0xffffu), a3 = bf2f(w.y >> 16), a4 = bf2f(w.z & 0xffffu), a5 = bf2f(w.z >> 16), a6 = bf2f(w.w & 0xffffu), a7 = bf2f(w.w >> 16);
            ss += ((a0 * a0 + a1 * a1) + (a2 * a2 + a3 * a3)) + ((a4 * a4 + a5 * a5) + (a6 * a6 + a7 * a7));
            if (Q8) am = fmaxf(fmaxf(fmaxf(am, fmaxf(fabsf(a0), fabsf(a1))), fmaxf(fabsf(a2), fabsf(a3))), fmaxf(fmaxf(fabsf(a4), fabsf(a5)), fmaxf(fabsf(a6), fabsf(a7)))); }
        ss = wave_sum(ss);
        const float rs = 1.0f / sqrtf(ss * (1.0f / D) + EPS);
        if (!Q8) { if (lane == 0) rstd[r] = rs; }
        else {
#pragma unroll
            for (int o = 1; o < 64; o <<= 1) am = fmaxf(am, __shfl_xor(am, o));
            const float inv = am > 0.f ? 127.0f / am : 0.f; if (lane == 0) rstd[r] = rs * am * (1.0f / 127.0f);
#pragma unroll
            for (int j = 0; j < 8; ++j) { const v4u w = wq[j]; unsigned lo, hi;
                { const int b0 = (int)rintf(bf2f(w.x & 0xffffu) * inv), b1 = (int)rintf(bf2f(w.x >> 16) * inv), b2 = (int)rintf(bf2f(w.y & 0xffffu) * inv), b3 = (int)rintf(bf2f(w.y >> 16) * inv);
                  lo = (unsigned)(b0 & 0xff) | ((unsigned)(b1 & 0xff) << 8) | ((unsigned)(b2 & 0xff) << 16) | ((unsigned)(b3 & 0xff) << 24); }
                { const int b0 = (int)rintf(bf2f(w.z & 0xffffu) * inv), b1 = (int)rintf(bf2f(w.z >> 16) * inv), b2 = (int)rintf(bf2f(w.w & 0xffffu) * inv), b3 = (int)rintf(bf2f(w.w >> 16) * inv);
                  hi = (unsigned)(b0 & 0xff) | ((unsigned)(b1 & 0xff) << 8) | ((unsigned)(b2 & 0xff) << 16) | ((unsigned)(b3 & 0xff) << 24); }
                ((v2u*)(A8 + (size_t)r * D))[lane + 64 * j] = (v2u){lo, hi}; }
        }
    }
}
__device__ __forceinline__ void final_phase(const bf16* Hprev, const bf16* HB3, float* out, const float* gain, const float* part, LAS float* red, int bx, int G, int gw, int NGW, int wave, int lane) {
    if (part) for (int hr = bx; hr < 256; hr += G) {
        const int r = M - 256 + hr, b = r / LP, p = r - b * LP;
        f32x4 v[2]; float ss = 0.f;
#pragma unroll
        for (int j = 0; j < 2; ++j) { const size_t c = (size_t)(512 * wave + 256 * j + 4 * lane); v[j] = bf4_to_f32(*(const v2u*)(Hprev + (size_t)r * D + c));
#pragma unroll
            for (int s = 0; s < 16; ++s) v[j] = v[j] + *(const f32x4*)(part + ((size_t)s * 256 + hr) * D + c);
            ss += (v[j].x * v[j].x + v[j].y * v[j].y) + (v[j].z * v[j].z + v[j].w * v[j].w); }
        ss = wave_sum(ss);
        if (lane == 0) red[wave] = ss;
        __syncthreads();
        float tot = 0.f;
#pragma unroll
        for (int w = 0; w < NWAVES; ++w) tot += red[w];
        __syncthreads();
        const float rs = 1.0f / sqrtf(tot * (1.0f / D) + EPS);
#pragma unroll
        for (int j = 0; j < 2; ++j) { const size_t c = (size_t)(512 * wave + 256 * j + 4 * lane); const f32x4 g = *(const f32x4*)(gain + c);
            *(f32x4*)(out + ((size_t)b * SEQ + (size_t)(p - 128)) * D + c) = v[j] * rs * g; }
    }
    for (int r = gw; r < (part ? M - 256 : M); r += NGW) {
        const int b = r / LP, p = r - b * LP;
        if (p < 128) continue;
        float ss = 0.f; v4u wq[8];
#pragma unroll
        for (int j = 0; j < 8; ++j) { const v4u w = ((const v4u*)(HB3 + (size_t)r * D))[lane + 64 * j]; wq[j] = w;
            const float a0 = bf2f(w.x & 0xffffu), a1 = bf2f(w.x >> 16), a2 = bf2f(w.y & 0xffffu), a3 = bf2f(w.y >> 16), a4 = bf2f(w.z & 0xffffu), a5 = bf2f(w.z >> 16), a6 = bf2f(w.w & 0xffffu), a7 = bf2f(w.w >> 16);
            ss += ((a0 * a0 + a1 * a1) + (a2 * a2 + a3 * a3)) + ((a4 * a4 + a5 * a5) + (a6 * a6 + a7 * a7)); }
        ss = wave_sum(ss);
        const float rs = 1.0f / sqrtf(ss * (1.0f / D) + EPS);
        float* orow = out + ((size_t)b * SEQ + (size_t)(p - 128)) * D;
#pragma unroll
        for (int j = 0; j < 8; ++j) { const v4u w = wq[j]; const int e0 = 8 * (lane + 64 * j);
            const f32x4 g0 = *(const f32x4*)(gain + e0), g1 = *(const f32x4*)(gain + e0 + 4);
            *(f32x4*)(orow + e0) = (f32x4){bf2f(w.x & 0xffffu), bf2f(w.x >> 16), bf2f(w.y & 0xffffu), bf2f(w.y >> 16)} * rs * g0;
            *(f32x4*)(orow + e0 + 4) = (f32x4){bf2f(w.z & 0xffffu), bf2f(w.z >> 16), bf2f(w.w & 0xffffu), bf2f(w.w >> 16)} * rs * g1; }
    }
}
constexpr int NSL = 16;
template <int MODE>
__device__ __forceinline__ void rows_phase(const float* x, const float* meta, float* H, bf16* XN, float* out, const float* gain, int gw, int NGW, int lane,
                                           const float* part = nullptr, LAS float* red = nullptr, int bx = 0, int G = 1, int wave = 0) {
    if (MODE != 0 && part) {
        for (int hr = bx; hr < 256; hr += G) {
            const int r = M - 256 + hr, b = r / LP, p = r - b * LP;
            f32x4 v[2]; float ss = 0.f;
#pragma unroll
            for (int j = 0; j < 2; ++j) { const size_t c = (size_t)(512 * wave + 256 * j + 4 * lane); v[j] = *(const f32x4*)(H + (size_t)r * D + c);
#pragma unroll
                for (int s = 0; s < NSL; ++s) v[j] = v[j] + *(const f32x4*)(part + ((size_t)s * 256 + hr) * D + c);
                if (MODE == 1) *(f32x4*)(H + (size_t)r * D + c) = v[j];
                ss += (v[j].x * v[j].x + v[j].y * v[j].y) + (v[j].z * v[j].z + v[j].w * v[j].w); }
            ss = wave_sum(ss);
            if (lane == 0) red[wave] = ss;
            __syncthreads();
            float tot = 0.f;
#pragma unroll
            for (int w = 0; w < NWAVES; ++w) tot += red[w];
            __syncthreads();
            const float rstd = 1.0f / sqrtf(tot * (1.0f / D) + EPS);
#pragma unroll
            for (int j = 0; j < 2; ++j) { const size_t c = (size_t)(512 * wave + 256 * j + 4 * lane); const f32x4 g = *(const f32x4*)(gain + c); const f32x4 y = v[j] * rstd * g;
                if (MODE == 1) { v2u w; w.x = pk2(y.x, y.y); w.y = pk2(y.z, y.w); *(v2u*)(XN + (size_t)r * D + c) = w; }
                else *(f32x4*)(out + ((size_t)b * SEQ + (size_t)(p - 128)) * D + c) = y; }
        }
    }
    const int MEND = (MODE != 0 && part) ? M - 256 : M;
    for (int r = gw; r < MEND; r += NGW) {
        const int b = r / LP, p = r - b * LP;
        if (MODE == 2 && p < 128) continue;
        const float* src; bool zero = false;
        if (MODE == 0) { if (p < NPAD) { zero = true; src = x; } else if (p < 128) src = meta + (size_t)(p - NPAD) * D; else src = x + ((size_t)b * SEQ + (size_t)(p - 128)) * D; }
        else src = H + (size_t)r * D;
        f32x4 v[16]; float ss = 0.f;
#pragma unroll
        for (int j = 0; j < 16; ++j) { v[j] = zero ? (f32x4){0.f, 0.f, 0.f, 0.f} : ((const f32x4*)src)[lane + 64 * j]; ss += (v[j].x * v[j].x + v[j].y * v[j].y) + (v[j].z * v[j].z + v[j].w * v[j].w); }
        ss = wave_sum(ss);
        const float rstd = 1.0f / sqrtf(ss * (1.0f / D) + EPS);
#pragma unroll
        for (int j = 0; j < 16; ++j) { const f32x4 g = ((const f32x4*)gain)[lane + 64 * j]; const f32x4 y = v[j] * rstd * g;
            if (MODE == 0) ((f32x4*)(H + (size_t)r * D))[lane + 64 * j] = v[j];
            if (MODE != 2) { v2u w; w.x = pk2(y.x, y.y); w.y = pk2(y.z, y.w); ((v2u*)(XN + (size_t)r * D))[lane + 64 * j] = w; }
            else ((f32x4*)(out + ((size_t)b * SEQ + (size_t)(p - 128)) * D))[lane + 64 * j] = y; }
    }
}
template <bool GU, bool HAS_GAIN = false>
__device__ __forceinline__ void transpose_item(const float* W, int K, int N, bf16* WT, LAS float* scr, int item, int lane, const float* gain = nullptr) {
    const int nblk = N / 32, kb = item / nblk, nb = item - kb * nblk, k0 = 64 * kb, n0 = 32 * nb;
    int drow0 = n0;
    if (GU) { const int hh = (n0 >= FF) ? 1 : 0, nn = n0 - hh * FF; drow0 = 256 * (nn >> 7) + 128 * hh + (nn & 127); }
    float wv[32];
#pragma unroll
    for (int i = 0; i < 32; ++i) wv[i] = W[(size_t)(k0 + 2 * i + (lane >> 5)) * N + n0 + (lane & 31)];
    if (HAS_GAIN) {
        float gv[32];
#pragma unroll
        for (int i = 0; i < 32; ++i) gv[i] = gain[k0 + 2 * i + (lane >> 5)];
#pragma unroll
        for (int i = 0; i < 32; ++i) wv[i] *= gv[i];
    }
#pragma unroll
    for (int i = 0; i < 32; ++i) scr[(2 * i + (lane >> 5)) * 33 + (lane & 31)] = wv[i];
    LDS_WAIT(); asm volatile("" ::: "memory");
    const int c = lane & 7;
#pragma unroll
    for (int j = 0; j < 4; ++j) { const int n = (lane >> 3) + 8 * j; const LAS float* s = scr + (8 * c) * 33 + n;
        v4u o; o.x = pk2(s[0 * 33], s[1 * 33]); o.y = pk2(s[2 * 33], s[3 * 33]); o.z = pk2(s[4 * 33], s[5 * 33]); o.w = pk2(s[6 * 33], s[7 * 33]);
        *(v4u*)(WT + (size_t)(drow0 + n) * K + k0 + 8 * c) = o; }
    LDS_WAIT(); asm volatile("" ::: "memory");
}

__device__ __forceinline__ void fwht32(float (&v)[32]) {
#pragma unroll
    for (int len = 1; len < 32; len <<= 1)
#pragma unroll
        for (int i = 0; i < 32; ++i) if (!(i & len)) { const float a = v[i], b = v[i + len]; v[i] = a + b; v[i + len] = a - b; }
#pragma unroll
    for (int i = 0; i < 32; ++i) v[i] *= 0.17677669529663687f;
}
__device__ __forceinline__ void transpose_item_rot(const float* W, int K, int N, bf16* WT, LAS float* scr, int item, int lane, unsigned* colmax_bits) {
    const int nblk = N / 32, kb = item / nblk, nb = item - kb * nblk, k0 = 64 * kb, n0 = 32 * nb;
    float wv[32];
#pragma unroll
    for (int i = 0; i < 32; ++i) wv[i] = W[(size_t)(k0 + 2 * i + (lane >> 5)) * N + n0 + (lane & 31)];
#pragma unroll
    for (int i = 0; i < 32; ++i) scr[(2 * i + (lane >> 5)) * 33 + (lane & 31)] = wv[i];
    LDS_WAIT(); asm volatile("" ::: "memory");
    { float v[32]; const int n = lane & 31, hb = 32 * (lane >> 5);
#pragma unroll
        for (int i = 0; i < 32; ++i) v[i] = scr[(hb + i) * 33 + n];
        fwht32(v);
        float m = 0.f;
#pragma unroll
        for (int i = 0; i < 32; ++i) { scr[(hb + i) * 33 + n] = v[i]; m = fmaxf(m, fabsf(v[i])); }
        if (colmax_bits) { m = fmaxf(m, __shfl_xor(m, 32)); if (lane < 32) atomicMax(colmax_bits + n0 + n, __float_as_uint(m)); } }
    LDS_WAIT(); asm volatile("" ::: "memory");
    const int c = lane & 7;
#pragma unroll
    for (int j = 0; j < 4; ++j) { const int n = (lane >> 3) + 8 * j; const LAS float* s = scr + (8 * c) * 33 + n;
        v4u o; o.x = pk2(s[0 * 33], s[1 * 33]); o.y = pk2(s[2 * 33], s[3 * 33]); o.z = pk2(s[4 * 33], s[5 * 33]); o.w = pk2(s[6 * 33], s[7 * 33]);
        *(v4u*)(WT + (size_t)(n0 + n) * K + k0 + 8 * c) = o; }
    LDS_WAIT(); asm volatile("" ::: "memory");
}
__device__ __forceinline__ unsigned q8pack(float a, float b, float c, float d, float inv) {
    const int b0 = (int)fminf(fmaxf(rintf(a * inv), -127.f), 127.f), b1 = (int)fminf(fmaxf(rintf(b * inv), -127.f), 127.f), b2 = (int)fminf(fmaxf(rintf(c * inv), -127.f), 127.f), b3 = (int)fminf(fmaxf(rintf(d * inv), -127.f), 127.f);
    return (unsigned)(b0 & 0xff) | ((unsigned)(b1 & 0xff) << 8) | ((unsigned)(b2 & 0xff) << 16) | ((unsigned)(b3 & 0xff) << 24);
}
__device__ __forceinline__ void rows_to_int8(const bf16* src, unsigned char* dst, const unsigned* maxbits, int nrows, int width, int gw, int NGW, int lane) {
    const int chunks = width / 8;
    for (int r = gw; r < nrows; r += NGW) {
        const float am = __uint_as_float(maxbits[r]), inv = am > 0.f ? 127.0f / am : 0.f;
        const v4u* s = (const v4u*)(src + (size_t)r * width); v2u* d = (v2u*)(dst + (size_t)r * width);
        for (int ci = lane; ci < chunks; ci += 64) { const v4u w = s[ci];
            v2u o; o.x = q8pack(bf2f(w.x & 0xffffu), bf2f(w.x >> 16), bf2f(w.y & 0xffffu), bf2f(w.y >> 16), inv); o.y = q8pack(bf2f(w.z & 0xffffu), bf2f(w.z >> 16), bf2f(w.w & 0xffffu), bf2f(w.w >> 16), inv);
            d[ci] = o; }
    }
}
constexpr int RQ_LANES = 4; constexpr float RQ_SCALE = 0.17677669529663687f;
__device__ __forceinline__ unsigned q8pack_fast(float a, float b, float c, float d, float s) {
    const unsigned t0 = __float_as_uint(fmaf(a, s, 12582912.0f)), t1 = __float_as_uint(fmaf(b, s, 12582912.0f)), t2 = __float_as_uint(fmaf(c, s, 12582912.0f)), t3 = __float_as_uint(fmaf(d, s, 12582912.0f));
    return __builtin_amdgcn_perm(__builtin_amdgcn_perm(t3, t2, 0x0c0c0400u), __builtin_amdgcn_perm(t1, t0, 0x0c0c0400u), 0x05040100u);
}
template <bool TOK>
__device__ __forceinline__ void act_rot_quant(const bf16* src, unsigned char* dst, unsigned* rowmax, int gw, int NGW, int lane) {
    constexpr int CH = FF / 8, NJ = (CH + 63) / 64;
    constexpr float RS = RQ_SCALE;
    for (int r = gw; r < M; r += NGW) {
        if (TOK && (r % LP) < 128) continue;
        const v4u* s = (const v4u*)(src + (size_t)r * FF); v2u* d = (v2u*)(dst + (size_t)r * FF);
        float v[NJ][8]; float am = 0.f;
#pragma unroll
        for (int j = 0; j < NJ; ++j) { const int ci = lane + 64 * j; v4u w = (v4u){0u, 0u, 0u, 0u}; if (ci < CH) w = s[ci];
            v[j][0] = __uint_as_float(w.x << 16); v[j][1] = __uint_as_float(w.x & 0xffff0000u); v[j][2] = __uint_as_float(w.y << 16); v[j][3] = __uint_as_float(w.y & 0xffff0000u);
            v[j][4] = __uint_as_float(w.z << 16); v[j][5] = __uint_as_float(w.z & 0xffff0000u); v[j][6] = __uint_as_float(w.w << 16); v[j][7] = __uint_as_float(w.w & 0xffff0000u); }
#pragma unroll
        for (int j = 0; j < NJ; ++j) {
#pragma unroll
            for (int len = 1; len < 8; len <<= 1)
#pragma unroll
                for (int i = 0; i < 8; ++i) if (!(i & len)) { const float x0 = v[j][i], x1 = v[j][i + len]; v[j][i] = x0 + x1; v[j][i + len] = x0 - x1; }
#pragma unroll
            for (int bit = 1; bit < RQ_LANES; bit <<= 1) { const float sg = (lane & bit) ? -1.0f : 1.0f;
#pragma unroll
                for (int i = 0; i < 8; ++i) v[j][i] = fmaf(v[j][i], sg, __shfl_xor(v[j][i], bit)); }
#pragma unroll
            for (int i = 0; i < 8; ++i) am = fmaxf(am, fabsf(v[j][i])); }
#pragma unroll
        for (int o = 1; o < 64; o <<= 1) am = fmaxf(am, __shfl_xor(am, o));
        const float qs = am > 0.f ? 127.0f / am : 0.f;
        if (lane == 0) rowmax[r] = __float_as_uint(am * RS);
#pragma unroll
        for (int j = 0; j < NJ; ++j) { const int ci = lane + 64 * j; v2u o; o.x = q8pack_fast(v[j][0], v[j][1], v[j][2], v[j][3], qs); o.y = q8pack_fast(v[j][4], v[j][5], v[j][6], v[j][7], qs); if (ci < CH) d[ci] = o; }
    }
}
__device__ __forceinline__ void colmax_item(const float* W, int K, int N, const float* gain, unsigned* colmax_bits, int item, int lane) {
    const int nblk = N / 32, kb = item / nblk, nb = item - kb * nblk, k0 = 64 * kb, n0 = 32 * nb;
    const int hh = (n0 >= FF) ? 1 : 0, nn = n0 - hh * FF, drow0 = 256 * (nn >> 7) + 128 * hh + (nn & 127);
    float wv[32], gv[32];
#pragma unroll
    for (int i = 0; i < 32; ++i) wv[i] = W[(size_t)(k0 + 2 * i + (lane >> 5)) * N + n0 + (lane & 31)];
#pragma unroll
    for (int i = 0; i < 32; ++i) gv[i] = gain[k0 + 2 * i + (lane >> 5)];
    float m = 0.f;
#pragma unroll
    for (int i = 0; i < 32; ++i) m = fmaxf(m, fabsf(wv[i] * gv[i]));
    m = fmaxf(m, __shfl_xor(m, 32));
    if (lane < 32) atomicMax(colmax_bits + drow0 + lane, __float_as_uint(m));
}
__device__ __forceinline__ void quant_item(const float* W, int K, int N, unsigned char* WT, LAS float* scr, int item, int lane, const float* gain, const float* colmax) {
    const int nblk = N / 32, kb = item / nblk, nb = item - kb * nblk, k0 = 64 * kb, n0 = 32 * nb;
    const int hh = (n0 >= FF) ? 1 : 0, nn = n0 - hh * FF, drow0 = 256 * (nn >> 7) + 128 * hh + (nn & 127);
    float wv[32], gv[32];
#pragma unroll
    for (int i = 0; i < 32; ++i) wv[i] = W[(size_t)(k0 + 2 * i + (lane >> 5)) * N + n0 + (lane & 31)];
#pragma unroll
    for (int i = 0; i < 32; ++i) gv[i] = gain[k0 + 2 * i + (lane >> 5)];
    const float cm = colmax[drow0 + (lane & 31)], inv = cm > 0.f ? 127.0f / cm : 0.f;
#pragma unroll
    for (int i = 0; i < 32; ++i) scr[(2 * i + (lane >> 5)) * 33 + (lane & 31)] = rintf((wv[i] * gv[i]) * inv);
    LDS_WAIT(); asm volatile("" ::: "memory");
    const int c = lane & 3;
#pragma unroll
    for (int ps = 0; ps < 2; ++ps) { const int n = (lane >> 2) + 16 * ps; const LAS float* s = scr + (16 * c) * 33 + n; unsigned wd[4];
#pragma unroll
        for (int w4 = 0; w4 < 4; ++w4) { const int b0 = (int)s[(4 * w4 + 0) * 33], b1 = (int)s[(4 * w4 + 1) * 33], b2 = (int)s[(4 * w4 + 2) * 33], b3 = (int)s[(4 * w4 + 3) * 33];
            wd[w4] = (unsigned)(b0 & 0xff) | ((unsigned)(b1 & 0xff) << 8) | ((unsigned)(b2 & 0xff) << 16) | ((unsigned)(b3 & 0xff) << 24); }
        *(v4u*)(WT + (size_t)(drow0 + n) * K + k0 + 16 * c) = (v4u){wd[0], wd[1], wd[2], wd[3]}; }
    LDS_WAIT(); asm volatile("" ::: "memory");
}
__device__ __forceinline__ void rows_init8(const float* x, const float* meta, unsigned char* XN8, float* rowfac, int gw, int NGW, int lane) {
    for (int r = gw; r < M; r += NGW) {
        const int b = r / LP, p = r - b * LP;
        const bool zero = p < NPAD; const float* src = (p < 128) ? meta + (size_t)(zero ? 0 : p - NPAD) * D : x + ((size_t)b * SEQ + (size_t)(p - 128)) * D;
        f32x4 v[16]; float ss = 0.f, am = 0.f;
#pragma unroll
        for (int j = 0; j < 16; ++j) { v[j] = zero ? (f32x4){0.f, 0.f, 0.f, 0.f} : ((const f32x4*)src)[lane + 64 * j]; ss += (v[j].x * v[j].x + v[j].y * v[j].y) + (v[j].z * v[j].z + v[j].w * v[j].w);
            am = fmaxf(fmaxf(am, fmaxf(fabsf(v[j].x), fabsf(v[j].y))), fmaxf(fabsf(v[j].z), fabsf(v[j].w))); }
        ss = wave_sum(ss);
#pragma unroll
        for (int o = 1; o < 64; o <<= 1) am = fmaxf(am, __shfl_xor(am, o));
        const float rs = 1.0f / sqrtf(ss * (1.0f / D) + EPS), amn = am * rs, inv = amn > 0.f ? 127.0f / amn : 0.f, sc = rs * inv;
        if (lane == 0) rowfac[r] = amn * (1.0f / 127.0f);
#pragma unroll
        for (int j = 0; j < 16; ++j) { const int b0 = (int)rintf(v[j].x * sc), b1 = (int)rintf(v[j].y * sc), b2 = (int)rintf(v[j].z * sc), b3 = (int)rintf(v[j].w * sc);
            ((unsigned*)(XN8 + (size_t)r * D))[lane + 64 * j] = (unsigned)(b0 & 0xff) | ((unsigned)(b1 & 0xff) << 8) | ((unsigned)(b2 & 0xff) << 16) | ((unsigned)(b3 & 0xff) << 24); }
    }
}

__device__ __forceinline__ void attn_unit(LAS unsigned char* lds, const bf16* PROJ, bf16* MG, const float* sinks, int b, int n, int g, int tid, int wave, int lane) {
    asm volatile("" : "+v"(tid), "+v"(lane));
    constexpr int RS = 160;
    LAS unsigned char* Kl = lds; LAS unsigned char* Vl = lds + 256 * RS;
    const long row_first = (long)b * LP + (long)(n - 1) * 128;
    { v4u kr[4], vr[4];
#pragma unroll
    for (int it = 0; it < 4; ++it) { const int c = tid + 512 * it, j = c >> 3, ch = c & 7;
        kr[it] = (v4u){0u, 0u, 0u, 0u}; vr[it] = (v4u){0u, 0u, 0u, 0u};
        if (n > 0 || j >= 128) { const bf16* rp = PROJ + (size_t)(row_first + j) * INW + 64 * g + 8 * ch; kr[it] = *(const v4u*)(rp + OFF_KA); vr[it] = *(const v4u*)(rp + OFF_VA); } }
#pragma unroll
    for (int it = 0; it < 4; ++it) { const int c = tid + 512 * it, j = c >> 3, ch = c & 7;
        *(LAS v4u*)(Kl + j * RS + 16 * ch) = kr[it]; *(LAS v4u*)(Vl + j * RS + 16 * ch) = vr[it]; } }
    __syncthreads();
    const int hq = 8 * g + wave, fr = lane & 15, q = lane >> 4, ta = fr >> 2, tp = lane & 3;
    const float slope2 = exp2f(-0.25f * (float)(hq + 1)) * LOG2E;
    const float sink2 = sinks[hq] * LOG2E;
    const float qscale = 0.125f * LOG2E;
    bf16x8 qn[2];
    { const size_t qrow = (size_t)b * LP + (size_t)n * 128 + (size_t)((n == 0 ? 112 : 0) + fr);
#pragma unroll
      for (int s = 0; s < 2; ++s) qn[s] = *(const bf16x8*)(PROJ + qrow * INW + OFF_QA + hq * 64 + 32 * s + 8 * q); }
    for (int qt = 0; qt < 8; ++qt) {
        if (n == 0 && qt < 7) {
            const size_t qrow0z = (size_t)b * LP + (size_t)(16 * qt);
#pragma unroll
            for (int k = 0; k < 2; ++k) { const int c = lane + 64 * k, row = c >> 3, ch = c & 7; *(v4u*)(MG + (qrow0z + row) * D + hq * 64 + 8 * ch) = (v4u){0u, 0u, 0u, 0u}; }
            continue; }
        const int i = 16 * qt + fr; const size_t qrow = (size_t)b * LP + (size_t)n * 128 + (size_t)i;
        bf16x8 qf[2];
#pragma unroll
        for (int s = 0; s < 2; ++s) qf[s] = qn[s];
        { const size_t qrown = qrow + (qt < 7 ? 16 : 0);
#pragma unroll
          for (int s = 0; s < 2; ++s) qn[s] = *(const bf16x8*)(PROJ + qrown * INW + OFF_QA + hq * 64 + 32 * s + 8 * q); }
        f32x4 sc[9];
#pragma unroll
        for (int t = 0; t < 9; ++t) { const LAS unsigned char* kp = Kl + (16 * (qt + t) + fr) * RS + 16 * q; f32x4 a = (f32x4){0.f, 0.f, 0.f, 0.f};
#pragma unroll
            for (int s = 0; s < 2; ++s) a = MFMA16(*(const LAS bf16x8*)(kp + 64 * s), qf[s], a);
            sc[t] = a; }
        float mx = -1e30f;
#pragma unroll
        for (int t = 0; t < 9; ++t)
#pragma unroll
            for (int r = 0; r < 4; ++r) { const int j = 16 * (qt + t) + 4 * q + r, dist = 128 + i - j, kpos = (n - 1) * 128 + j; const bool ok = dist >= 0 && dist < 128 && kpos >= NPAD;
                const float val = ok ? sc[t][r] * qscale - slope2 * (float)dist : -1e30f; sc[t][r] = val; mx = fmaxf(mx, val); }
        mx = fmaxf(mx, __shfl_xor(mx, 16)); mx = fmaxf(mx, __shfl_xor(mx, 32));
        const float m2 = fmaxf(mx, sink2);
        float sum = 0.f;
#pragma unroll
        for (int t = 0; t < 9; ++t)
#pragma unroll
            for (int r = 0; r < 4; ++r) { const float p = __builtin_amdgcn_exp2f(sc[t][r] - m2); sc[t][r] = p; sum += p; }
        sum += __shfl_xor(sum, 16); sum += __shfl_xor(sum, 32);
        const float inv = 1.0f / (sum + __builtin_amdgcn_exp2f(sink2 - m2));
        f32x4 o[4];
#pragma unroll
        for (int dt = 0; dt < 4; ++dt) o[dt] = (f32x4){0.f, 0.f, 0.f, 0.f};
#pragma unroll
        for (int sp = 0; sp < 5; ++sp) { const int T0 = qt + 2 * sp; int T1 = T0 + 1; if (T1 > 15) T1 = 15;
            v4u pw; pw.x = pk2(sc[2 * sp][0], sc[2 * sp][1]); pw.y = pk2(sc[2 * sp][2], sc[2 * sp][3]);
            if (2 * sp + 1 < 9) { pw.z = pk2(sc[(2 * sp + 1) % 9][0], sc[(2 * sp + 1) % 9][1]); pw.w = pk2(sc[(2 * sp + 1) % 9][2], sc[(2 * sp + 1) % 9][3]); } else { pw.z = 0u; pw.w = 0u; }
            const bf16x8 pb = __builtin_bit_cast(bf16x8, pw);
#pragma unroll
            for (int dt = 0; dt < 4; ++dt) { const s16x4 lo = ds_tr16(Vl + (16 * T0 + 4 * q + ta) * RS + (16 * dt + 4 * tp) * 2), hi = ds_tr16(Vl + (16 * T1 + 4 * q + ta) * RS + (16 * dt + 4 * tp) * 2);
                o[dt] = MFMA16(cat8(lo, hi), pb, o[dt]); } }
        LAS unsigned char* Ow = lds + 81920 + wave * 2304;
#pragma unroll
        for (int dt = 0; dt < 4; ++dt) { const f32x4 ov = o[dt] * inv; v2u w; w.x = pk2(ov[0], ov[1]); w.y = pk2(ov[2], ov[3]); *(LAS v2u*)(Ow + fr * 144 + (16 * dt + 4 * q) * 2) = w; }
        LDS_WAIT();
        const size_t qrow0 = (size_t)b * LP + (size_t)n * 128 + (size_t)(16 * qt);
#pragma unroll
        for (int k = 0; k < 2; ++k) { const int c = lane + 64 * k, row = c >> 3, ch = c & 7; const v4u v = *(const LAS v4u*)(Ow + row * 144 + 16 * ch); *(v4u*)(MG + (qrow0 + row) * D + hq * 64 + 8 * ch) = v; }
        LDS_WAIT();
    }
    __syncthreads();
}

__device__ __forceinline__ void kv_unit(LAS unsigned char* lds, const bf16* PROJ, bf16* ST, int b, int h, int n, int tid, int wave, int lane) {
    asm volatile("" : "+v"(tid), "+v"(lane));
    constexpr int RS = 544;
    LAS unsigned char* Kl = lds; LAS unsigned char* Vl = lds + 128 * RS;
    const float lg = log2_gamma(h);
    const size_t row0 = (size_t)b * LP + (size_t)n * 128;
    v4u kr[8], vr[8];
#pragma unroll
    for (int it = 0; it < 8; ++it) { const int c = tid + 512 * it, j = c >> 5, ch = c & 31; const bf16* rp = PROJ + (row0 + j) * INW + 256 * h + 8 * ch;
        kr[it] = *(const v4u*)(rp + OFF_KR); vr[it] = *(const v4u*)(rp + OFF_VR); }
#pragma unroll
    for (int it = 0; it < 8; ++it) { const int c = tid + 512 * it, j = c >> 5, ch = c & 31;
        v4u kv = kr[it]; const v4u vv = vr[it];
        const float w = __builtin_amdgcn_exp2f((float)(127 - j) * lg) * 0.0625f;
        kv.x = pk2(bf2f(kv.x & 0xffffu) * w, bf2f(kv.x >> 16) * w); kv.y = pk2(bf2f(kv.y & 0xffffu) * w, bf2f(kv.y >> 16) * w);
        kv.z = pk2(bf2f(kv.z & 0xffffu) * w, bf2f(kv.z >> 16) * w); kv.w = pk2(bf2f(kv.w & 0xffffu) * w, bf2f(kv.w >> 16) * w);
        *(LAS v4u*)(Kl + j * RS + 16 * ch) = kv; *(LAS v4u*)(Vl + j * RS + 16 * ch) = vv; }
    __syncthreads();
    const int fr = lane & 15, q = lane >> 4, ta = fr >> 2, tp = lane & 3;
    const int dt0 = 4 * (wave & 3), et0 = 8 * (wave >> 2);
    f32x4 acc[4][8];
#pragma unroll
    for (int a = 0; a < 4; ++a)
#pragma unroll
        for (int e = 0; e < 8; ++e) acc[a][e] = (f32x4){0.f, 0.f, 0.f, 0.f};
#pragma unroll
    for (int s = 0; s < 4; ++s) {
        bf16x8 af[4], bfr[8];
#pragma unroll
        for (int a = 0; a < 4; ++a) { const LAS unsigned char* p = Kl + (32 * s + 8 * q + ta) * RS + (16 * (dt0 + a) + 4 * tp) * 2; af[a] = cat8(ds_tr16(p), ds_tr16(p + 4 * RS)); }
#pragma unroll
        for (int e = 0; e < 8; ++e) { const LAS unsigned char* p = Vl + (32 * s + 8 * q + ta) * RS + (16 * (et0 + e) + 4 * tp) * 2; bfr[e] = cat8(ds_tr16(p), ds_tr16(p + 4 * RS)); }
#pragma unroll
        for (int a = 0; a < 4; ++a)
#pragma unroll
            for (int e = 0; e < 8; ++e) acc[a][e] = MFMA16(af[a], bfr[e], acc[a][e]);
    }
    bf16* sp = ST + ((size_t)(n * 2 + b) * 8 + h) * 65536;
    __syncthreads();
#pragma unroll
    for (int a = 0; a < 4; ++a)
#pragma unroll
        for (int e = 0; e < 8; ++e) { v2u w; w.x = pk2(acc[a][e][0], acc[a][e][1]); w.y = pk2(acc[a][e][2], acc[a][e][3]); *(LAS v2u*)(lds + (16 * (et0 + e) + fr) * 528 + (16 * (dt0 + a) + 4 * q) * 2) = w; }
    __syncthreads();
#pragma unroll
    for (int it = 0; it < 16; ++it) { const int c = tid + 512 * it, row = ((c >> 5) + 37 * (int)blockIdx.x) & 255, ch = c & 31; const v4u v = *(const LAS v4u*)(lds + row * 528 + 16 * ch); *(v4u*)(sp + (size_t)row * 256 + 8 * ch) = v; }
    __syncthreads();
}
#define BAR_LDS() asm volatile("s_waitcnt lgkmcnt(0)\n\ts_barrier" ::: "memory")
__device__ __forceinline__ void kv_phase(LAS unsigned char* lds, const bf16* PROJ, bf16* ST, int bx, int G, int tid, int wave, int lane) {
    asm volatile("" : "+v"(tid), "+v"(lane));
    constexpr int RS = 544;
    LAS unsigned char* Kl = lds; LAS unsigned char* Vl = lds + 128 * RS;
    const int dt0 = 4 * (wave & 3), et0 = 8 * (wave >> 2);
    v4u kr[8], vr[8];
#define KV_LOAD(u_) do { const int b_ = ((u_) & 15) >> 3, h_ = (u_) & 7, n_ = (u_) >> 4; const size_t r0_ = (size_t)b_ * LP + (size_t)n_ * 128; \
        _Pragma("unroll") for (int it = 0; it < 8; ++it) { const int c = tid + 512 * it, j = c >> 5, ch = c & 31; const bf16* rp = PROJ + (r0_ + j) * INW + 256 * h_ + 8 * ch; \
            kr[it] = *(const v4u*)(rp + OFF_KR); vr[it] = *(const v4u*)(rp + OFF_VR); } } while (0)
    int u = bx;
    if (u < 1024) KV_LOAD(u);
    for (; u < 1024; u += G) {
        asm volatile("" : "+v"(tid), "+v"(lane));
        const int fr = lane & 15, q = lane >> 4, ta = fr >> 2, tp = lane & 3;
        const int b = (u & 15) >> 3, h = u & 7, n = u >> 4;
        const float lg = log2_gamma(h);
#pragma unroll
        for (int it = 0; it < 8; ++it) { const int c = tid + 512 * it, j = c >> 5, ch = c & 31;
            v4u kv = kr[it]; const v4u vv = vr[it];
            const float w = __builtin_amdgcn_exp2f((float)(127 - j) * lg) * 0.0625f;
            kv.x = pk2(bf2f(kv.x & 0xffffu) * w, bf2f(kv.x >> 16) * w); kv.y = pk2(bf2f(kv.y & 0xffffu) * w, bf2f(kv.y >> 16) * w);
            kv.z = pk2(bf2f(kv.z & 0xffffu) * w, bf2f(kv.z >> 16) * w); kv.w = pk2(bf2f(kv.w & 0xffffu) * w, bf2f(kv.w >> 16) * w);
            *(LAS v4u*)(Kl + j * RS + 16 * ch) = kv; *(LAS v4u*)(Vl + j * RS + 16 * ch) = vv; }
        BAR_LDS();
        f32x4 acc[4][8];
#pragma unroll
        for (int a = 0; a < 4; ++a)
#pragma unroll
            for (int e = 0; e < 8; ++e) acc[a][e] = (f32x4){0.f, 0.f, 0.f, 0.f};
#pragma unroll
        for (int s = 0; s < 4; ++s) {
            bf16x8 af[4], bfr[8];
#pragma unroll
            for (int a = 0; a < 4; ++a) { const LAS unsigned char* p = Kl + (32 * s + 8 * q + ta) * RS + (16 * (dt0 + a) + 4 * tp) * 2; af[a] = cat8(ds_tr16(p), ds_tr16(p + 4 * RS)); }
#pragma unroll
            for (int e = 0; e < 8; ++e) { const LAS unsigned char* p = Vl + (32 * s + 8 * q + ta) * RS + (16 * (et0 + e) + 4 * tp) * 2; bfr[e] = cat8(ds_tr16(p), ds_tr16(p + 4 * RS)); }
#pragma unroll
            for (int a = 0; a < 4; ++a)
#pragma unroll
                for (int e = 0; e < 8; ++e) acc[a][e] = MFMA16(af[a], bfr[e], acc[a][e]);
        }
        v2u pk[4][8];
#pragma unroll
        for (int a = 0; a < 4; ++a)
#pragma unroll
            for (int e = 0; e < 8; ++e) { pk[a][e].x = pk2(acc[a][e][0], acc[a][e][1]); pk[a][e].y = pk2(acc[a][e][2], acc[a][e][3]); }
        __builtin_amdgcn_sched_barrier(0);
        { const int un = (u + G < 1024) ? u + G : u; KV_LOAD(un); }
        __builtin_amdgcn_sched_barrier(0);
        bf16* sp = ST + ((size_t)(n * 2 + b) * 8 + h) * 65536;
        BAR_LDS();
#pragma unroll
        for (int a = 0; a < 4; ++a)
#pragma unroll
            for (int e = 0; e < 8; ++e) *(LAS v2u*)(lds + (16 * (et0 + e) + fr) * 528 + (16 * (dt0 + a) + 4 * q) * 2) = pk[a][e];
        BAR_LDS();
#pragma unroll
        for (int it = 0; it < 16; ++it) { const int c = tid + 512 * it, row = ((c >> 5) + 37 * bx) & 255, ch = c & 31; const v4u v = *(const LAS v4u*)(lds + row * 528 + 16 * ch); *(v4u*)(sp + (size_t)row * 256 + 8 * ch) = v; }
        BAR_LDS();
    }
#undef KV_LOAD
}
__device__ __forceinline__ void scan_phase(bf16* ST, int gtid, int nthreads) {
    for (int idx = gtid; idx < 16 * 8192; idx += nthreads) {
        const int bh = idx >> 13, v = idx & 8191, h = bh & 7;
        const float cd = exp2f(128.0f * log2_gamma(h));
        bf16* p = ST + (size_t)bh * 65536 + (size_t)v * 8; constexpr size_t NS = (size_t)16 * 65536;
        float s[8];
#pragma unroll
        for (int k = 0; k < 8; ++k) s[k] = 0.f;
        for (int nb = 0; nb < NCH; nb += 13) {
            v4u in[13];
#pragma unroll
            for (int k = 0; k < 13; ++k) in[k] = (nb + k < NCH - 1) ? *(const v4u*)(p + (size_t)(nb + k) * NS) : (v4u){0u, 0u, 0u, 0u};
#pragma unroll
            for (int k = 0; k < 13; ++k) { v4u o; o.x = pk2(s[0], s[1]); o.y = pk2(s[2], s[3]); o.z = pk2(s[4], s[5]); o.w = pk2(s[6], s[7]); *(v4u*)(p + (size_t)(nb + k) * NS) = o;
                s[0] = s[0] * cd + bf2f(in[k].x & 0xffffu); s[1] = s[1] * cd + bf2f(in[k].x >> 16); s[2] = s[2] * cd + bf2f(in[k].y & 0xffffu); s[3] = s[3] * cd + bf2f(in[k].y >> 16);
                s[4] = s[4] * cd + bf2f(in[k].z & 0xffffu); s[5] = s[5] * cd + bf2f(in[k].z >> 16); s[6] = s[6] * cd + bf2f(in[k].w & 0xffffu); s[7] = s[7] * cd + bf2f(in[k].w >> 16); }
        }
    }
}
__device__ __forceinline__ void ret_unit(LAS unsigned char* lds, const bf16* PROJ, const bf16* ST, bf16* MG, int b, int h, int n, int tid, int wave, int lane) {
    asm volatile("" : "+v"(tid), "+v"(lane));
    constexpr int RS = 544, SRS = 528, SBUF = 64 * SRS;
    LAS unsigned char* Kl = lds; LAS unsigned char* Vl = lds + 128 * RS;
    const float lg = log2_gamma(h);
    const size_t row0 = (size_t)b * LP + (size_t)n * 128;
    const bf16* sp = ST + ((size_t)(n * 2 + b) * 8 + h) * 65536;
    v4u sr[4];
#define RET_LOADST(c) do { _Pragma("unroll") for (int i_ = 0; i_ < 4; ++i_) { const int pc_ = tid + 512 * i_; sr[i_] = *(const v4u*)(sp + (size_t)(64 * (c) + (pc_ >> 5)) * 256 + 8 * (pc_ & 31)); } } while (0)
#define RET_WRITEST(buf) do { _Pragma("unroll") for (int i_ = 0; i_ < 4; ++i_) { const int pc_ = tid + 512 * i_; *(LAS v4u*)(Kl + (buf) * SBUF + (pc_ >> 5) * SRS + 16 * (pc_ & 31)) = sr[i_]; } } while (0)
    RET_LOADST(0);
    { v4u kr[8], vr[8];
#pragma unroll
    for (int it = 0; it < 8; ++it) { const int c = tid + 512 * it, j = c >> 5, ch = c & 31; const bf16* rp = PROJ + (row0 + j) * INW + 256 * h + 8 * ch;
        kr[it] = *(const v4u*)(rp + OFF_KR); vr[it] = *(const v4u*)(rp + OFF_VR); }
#pragma unroll
    for (int it = 0; it < 8; ++it) { const int c = tid + 512 * it, j = c >> 5, ch = c & 31;
        *(LAS v4u*)(Kl + j * RS + 16 * ch) = kr[it]; *(LAS v4u*)(Vl + j * RS + 16 * ch) = vr[it]; } }
    __syncthreads();
    const int fr = lane & 15, q = lane >> 4, ta = fr >> 2, tp = lane & 3;
    const int i = 16 * wave + fr; const size_t qrow = row0 + (size_t)i;
    bf16x8 qf[8];
#pragma unroll
    for (int s = 0; s < 8; ++s) qf[s] = *(const bf16x8*)(PROJ + qrow * INW + OFF_QR + 256 * h + 32 * s + 8 * q);
    v2u spk[8];
    const bool live = (n > 0) || (wave == NWAVES - 1);
#pragma unroll
    for (int jt = 0; jt < 8; ++jt) { f32x4 a = (f32x4){0.f, 0.f, 0.f, 0.f};
        if (jt <= wave && live) { const LAS unsigned char* kp = Kl + (16 * jt + fr) * RS + 16 * q;
#pragma unroll
            for (int s = 0; s < 8; ++s) a = MFMA16(*(const LAS bf16x8*)(kp + 64 * s), qf[s], a);
#pragma unroll
            for (int r = 0; r < 4; ++r) { const int j = 16 * jt + 4 * q + r; a[r] = (i >= j) ? a[r] * __builtin_amdgcn_exp2f((float)(i - j) * lg) * 0.0625f : 0.f; } }
        spk[jt].x = pk2(a[0], a[1]); spk[jt].y = pk2(a[2], a[3]); }
    __syncthreads();
    RET_WRITEST(0); RET_LOADST(1);
    __syncthreads();
    f32x4 acc[16];
#pragma unroll
    for (int et = 0; et < 16; ++et) acc[et] = (f32x4){0.f, 0.f, 0.f, 0.f};
#pragma unroll
    for (int c = 0; c < 4; ++c) {
        const LAS unsigned char* sb = Kl + (c & 1) * SBUF + fr * SRS + 16 * q;
        if (live) {
#pragma unroll
        for (int e4 = 0; e4 < 4; ++e4)
#pragma unroll
            for (int s = 0; s < 8; ++s) acc[4 * c + e4] = MFMA16(*(const LAS bf16x8*)(sb + 16 * e4 * SRS + 64 * s), qf[s], acc[4 * c + e4]);
        }
        if (c < 3) { RET_WRITEST((c + 1) & 1); if (c < 2) RET_LOADST(c + 2); __syncthreads(); }
    }
#undef RET_LOADST
#undef RET_WRITEST
    const float cw = __builtin_amdgcn_exp2f((float)(i + 1) * lg);
#pragma unroll
    for (int et = 0; et < 16; ++et) acc[et] = acc[et] * cw;
#pragma unroll
    for (int s2 = 0; s2 < 4; ++s2)
        if (2 * s2 <= wave && live) { v4u pw; pw.x = spk[2 * s2].x; pw.y = spk[2 * s2].y; pw.z = spk[2 * s2 + 1].x; pw.w = spk[2 * s2 + 1].y; const bf16x8 pb = __builtin_bit_cast(bf16x8, pw);
#pragma unroll
            for (int et = 0; et < 16; ++et) { const LAS unsigned char* p = Vl + (32 * s2 + 4 * q + ta) * RS + (16 * et + 4 * tp) * 2; acc[et] = MFMA16(cat8(ds_tr16(p), ds_tr16(p + 16 * RS)), pb, acc[et]); } }
    float ss = 0.f;
#pragma unroll
    for (int et = 0; et < 16; ++et) ss += (acc[et][0] * acc[et][0] + acc[et][1] * acc[et][1]) + (acc[et][2] * acc[et][2] + acc[et][3] * acc[et][3]);
    ss += __shfl_xor(ss, 16); ss += __shfl_xor(ss, 32);
    const float rstd = 1.0f / sqrtf(ss * (1.0f / 256.0f) + EPS);
    __syncthreads();
    LAS unsigned char* Rw = lds + wave * 16640;
#pragma unroll
    for (int et = 0; et < 16; ++et) *(LAS f32x4*)(Rw + fr * 1040 + (16 * et + 4 * q) * 4) = acc[et] * rstd;
    LDS_WAIT();
#pragma unroll
    for (int k = 0; k < 8; ++k) { const int c = lane + 64 * k, row = c >> 5, ch = c & 31; const size_t grow = row0 + (size_t)(16 * wave + row);
        const f32x4 a0 = *(const LAS f32x4*)(Rw + row * 1040 + 32 * ch), a1 = *(const LAS f32x4*)(Rw + row * 1040 + 32 * ch + 16);
        const v4u gw = *(const v4u*)(PROJ + grow * INW + OFF_GR + 256 * h + 8 * ch);
        v4u w; w.x = pk2(a0[0] * pg8::silu_f(bf2f(gw.x & 0xffffu)), a0[1] * pg8::silu_f(bf2f(gw.x >> 16))); w.y = pk2(a0[2] * pg8::silu_f(bf2f(gw.y & 0xffffu)), a0[3] * pg8::silu_f(bf2f(gw.y >> 16)));
        w.z = pk2(a1[0] * pg8::silu_f(bf2f(gw.z & 0xffffu)), a1[1] * pg8::silu_f(bf2f(gw.z >> 16))); w.w = pk2(a1[2] * pg8::silu_f(bf2f(gw.w & 0xffffu)), a1[3] * pg8::silu_f(bf2f(gw.w >> 16)));
        *(v4u*)(MG + grow * D + 2048 + 256 * h + 8 * ch) = w; }
    __syncthreads();
}

template <bool GU, bool HAS_GAIN>
__device__ __forceinline__ void convert_in_tail(int nunits, int G, int bx, int wave, int lane, const float* W, int K, int N, bf16* WT, LAS float* scr, const float* gain) {
    const int rounds = (nunits + G - 1) / G, nidle = rounds * G - nunits;
    int first = G - nidle, nconv = nidle; if (nidle < 8) { first = 0; nconv = G; }
    if (bx < first) return;
    const int nitems = (K / 64) * (N / 32);
    for (int it = (bx - first) * NWAVES + wave; it < nitems; it += nconv * NWAVES) transpose_item<GU, HAS_GAIN>(W, K, N, WT, scr, it, lane, gain);
}

constexpr int N_PHASES = 13;
#ifndef PROBE_REPS
#define PROBE_REPS {1,1,1,1,1,1,1,1,1,1,1,1,1}
#endif
#ifndef PROBE_T4
#define PROBE_T4 1
#endif
constexpr int REP[N_PHASES] = PROBE_REPS;
struct Args { const float* in[14]; float* out; unsigned char* ws; int ph_lo, ph_hi; };
__global__ void __launch_bounds__(NWAVES * 64, 2) hybrid_fwd(Args args) {
    extern __shared__ __attribute__((aligned(16))) unsigned char lds_raw[];
    LAS unsigned char* lds = (LAS unsigned char*)lds_raw;
    volatile LAS unsigned* MISC = (volatile LAS unsigned*)(lds + MISC_OFF);
    const int tid = threadIdx.x, lane = tid & 63, wave = __builtin_amdgcn_readfirstlane(tid >> 6);
    const int G = gridDim.x, bx = blockIdx.x, vcu = (G % 8 == 0) ? (bx % 8) * (G / 8) + bx / 8 : bx;
    const int gw = vcu * NWAVES + wave, NGW = G * NWAVES;
    unsigned char* ws = args.ws;
    const float* x = args.in[0]; const float* meta = args.in[1]; const float* g_ffn1 = args.in[2]; const float* w_gu1 = args.in[3]; const float* w_d1 = args.in[4];
    const float* g_mix = args.in[5]; const float* w_in = args.in[6]; const float* b_in = args.in[7]; const float* sinks = args.in[8]; const float* w_out = args.in[9];
    const float* g_ffn2 = args.in[10]; const float* w_gu2 = args.in[11]; const float* w_d2 = args.in[12]; const float* g_fin = args.in[13];
    bf16* HB1 = (bf16*)(ws + WS_H); bf16* HB3 = (bf16*)(ws + WS_H + 130 * MiB);
    bf16* XN = (bf16*)(ws + WS_XN); bf16* ACT = (bf16*)(ws + WS_ACT); bf16* PROJ = ACT; bf16* MG = XN; float* SQ1 = (float*)(ws + WS_ST + 32 * MiB);
    bf16* HB2 = (bf16*)(ws + WS_HB2); float* RSTD = (float*)(ws + WS_RSTD);
    bf16* WGU = (bf16*)(ws + WS_WGU); bf16* WD = (bf16*)(ws + WS_WD); bf16* WIN = (bf16*)(ws + WS_WIN); bf16* WOUT = (bf16*)(ws + WS_WOUT); bf16* ST = (bf16*)(ws + WS_ST);
    for (int u = tid; u < (LDS_BYTES - MISC_OFF) / 4; u += NWAVES * 64) ((LAS unsigned*)(lds + MISC_OFF))[u] = 0u;
    __syncthreads();
    const int lo = args.ph_lo, hi = args.ph_hi;
    XcdBarrier bar; bar.bar = (unsigned*)(ws + WS_CTL) + CW_BAR; bar.x = 0; bar.st = MISC + 8;
    if (hi - lo > 1) bar = xcd_barrier_post((unsigned*)(ws + WS_CTL) + CW_BAR, MISC + 8);
#define IN(k) (lo <= (k) && (k) < hi)
#define SEAM(k) do { if (IN(k) && IN((k) + 1)) xcd_barrier(bar); } while (0)
    LAS float* scr = (LAS float*)(lds + wave * 16384);
    LAS float* red = (LAS float*)(lds + 135168);

    unsigned* ROWMAXD1 = (unsigned*)(ws + WS_ROWMAXD1); unsigned* ROWMAXD2 = (unsigned*)(ws + WS_ROWMAXD2); float* COLMAXD1 = (float*)(ws + WS_COLMAXD1); float* COLMAXD2 = (float*)(ws + WS_COLMAXD2);
    unsigned char* ACT8 = (unsigned char*)(ws + WS_XN); unsigned char* WD8 = (unsigned char*)(ws + WS_WD8);
    float* ROWFAC = (float*)(ws + WS_ROWFAC); float* COLMAX1 = (float*)(ws + WS_COLMAX1); float* COLMAX2 = (float*)(ws + WS_COLMAX2);
    unsigned char* XN8 = (unsigned char*)XN; unsigned char* WGU8 = (unsigned char*)WGU; unsigned char* WGU8b = WGU8 + (size_t)NGU * D;
    if (IN(0)) {
        constexpr int I_GU = (D / 64) * (NGU / 32), I_D = (FF / 64) * (D / 32), I_IN = (D / 64) * (INW / 32);
        for (int it = gw; it < 2 * I_GU + I_D + I_IN; it += NGW) { int r = it;
            if (r < I_GU) { colmax_item(w_gu1, D, NGU, g_ffn1, (unsigned*)COLMAX1, r, lane); continue; } r -= I_GU;
            if (r < I_GU) { colmax_item(w_gu2, D, NGU, g_ffn2, (unsigned*)COLMAX2, r, lane); continue; } r -= I_GU;
            if (r < I_D) { transpose_item_rot(w_d1, FF, D, WD, scr, r, lane, (unsigned*)COLMAXD1); continue; } r -= I_D;
            transpose_item<false, true>(w_in, D, INW, WIN, scr, r, lane, g_mix); }
        rows_init8(x, meta, XN8, ROWFAC, gw, NGW, lane);
        xcd_barrier(bar);
        for (int it = gw; it < I_GU; it += NGW) quant_item(w_gu1, D, NGU, WGU8, scr, it, lane, g_ffn1, COLMAX1);
        rows_to_int8(WD, WD8, (const unsigned*)COLMAXD1, D, FF, gw, NGW, lane);
    }
    SEAM(0);
    if (IN(1)) for (int rep = 0; rep < REP[1]; ++rep) { pg8::Gemm g{(const bf16*)XN8, (const bf16*)WGU8, M, NGU, D}; pg8::StaticOrder S; S.init(M, NGU, G, bx); pg8::EpiSwiGLU8 E{ACT, FF, ROWFAC, COLMAX1};
        pg8::gemm_phase<pg8::EpiSwiGLU8, pg8::StaticOrder, true, true, true>(lds, g, S, E);
        convert_in_tail<false, false>((M / 256) * (NGU / 256), G, bx, wave, lane, w_out, D, D, WOUT, scr, nullptr);
        xcd_barrier(bar);
        act_rot_quant<false>(ACT, ACT8, ROWMAXD1, gw, NGW, lane); }
    SEAM(1);
    if (IN(2)) for (int rep = 0; rep < REP[2]; ++rep) { pg8::Gemm g{(const bf16*)ACT8, (const bf16*)WD8, M, D, FF}; pg8::SplitOrder S; S.init(M, D, FF / 128, G, bx, NSL_D1); pg8::EpiResid8<true> E{HB1, D, 0.5f, (float*)ST, x, meta, nullptr, LP, NPAD, SEQ, ROWMAXD1, COLMAXD1, SQ1, M};
        pg8::gemm_phase<pg8::EpiResid8<true>, pg8::SplitOrder, true, true, true>(lds, g, S, E);
        { constexpr int I_GU = (D / 64) * (NGU / 32), I_TAIL = (int)(I_GU * P2_TAIL_FRAC); const int nbusy = (G > 4 * (D / 256) * NSL_D1) ? (D / 256) * NSL_D1 : 0;
          if (bx >= nbusy) for (int it = (bx - nbusy) * NWAVES + wave; it < I_TAIL; it += (G - nbusy) * NWAVES) quant_item(w_gu2, D, NGU, WGU8b, scr, it, lane, g_ffn2, COLMAX2); } }
    SEAM(2);
    if (IN(3)) for (int rep = 0; rep < REP[3]; ++rep) {
        stats_phase<true>(x, nullptr, HB1, RSTD, (const float*)ST, red, bx, G, gw, NGW, wave, lane, nullptr, SQ1);
        constexpr int I_GU = (D / 64) * (NGU / 32), I_D = (FF / 64) * (D / 32);
        for (int it = (int)(I_GU * P2_TAIL_FRAC) + gw; it < I_GU; it += NGW) quant_item(w_gu2, D, NGU, WGU8b, scr, it, lane, g_ffn2, COLMAX2);
    }
    SEAM(3);
    if (IN(4)) for (int rep = 0; rep < REP[4]; ++rep) { pg8::Gemm g{HB1, WIN, M, INW, D}; pg8::StaticOrder S; S.init(M, INW, G, bx); pg8::EpiProj E{PROJ, INW, b_in, LP, NPAD, RSTD};
        pg8::gemm_phase<pg8::EpiProj, pg8::StaticOrder, true, true>(lds, g, S, E);
        { const int nunits = (M / 256) * (INW / 256), rounds = (nunits + G - 1) / G, nidle = rounds * G - nunits; int first = G - nidle, nconv = nidle; if (nidle < 8) { first = 0; nconv = G; }
          if (bx >= first) for (int it = (bx - first) * NWAVES + wave; it < (FF / 64) * (D / 32); it += nconv * NWAVES) transpose_item_rot(w_d2, FF, D, WD, scr, it, lane, (unsigned*)COLMAXD2); } }
    SEAM(4);
    if (IN(5)) for (int rep = 0; rep < REP[5]; ++rep) {
#ifndef PROBE_KVREP
#define PROBE_KVREP 1
#endif
#ifndef PROBE_ATREP
#define PROBE_ATREP 1
#endif
        for (int r2 = 0; r2 < PROBE_KVREP; ++r2)
        kv_phase(lds, PROJ, ST, bx, G, tid, wave, lane);
        __syncthreads();
        for (int r2 = 0; r2 < PROBE_ATREP; ++r2)
        for (int u = bx; u < 512; u += G) {   int n, b, g; if (u < 512) { n = 1 + (u >> 3); b = (u >> 2) & 1; g = u & 3; } else { n = 0; b = (u - 512) >> 2; g = u & 3; }
            attn_unit(lds, PROJ, MG, sinks, b, n, g, tid, wave, lane); }
    }
    SEAM(5);
    if (IN(6)) scan_phase(ST, vcu * (NWAVES * 64) + tid, G * NWAVES * 64);
    SEAM(6);
    if (IN(7)) for (int rep = 0; rep < REP[7]; ++rep) {
        for (int u = bx; u < 1024; u += G) { int n, bh; if (u < 1024) { n = 1 + (u >> 4); bh = u & 15; } else { n = 0; bh = u - 1024; }
            ret_unit(lds, PROJ, ST, MG, bh >> 3, bh & 7, n, tid, wave, lane); }
    }
    SEAM(7);
    if (IN(8)) for (int rep = 0; rep < REP[8]; ++rep) { pg8::Gemm g{MG, WOUT, M, D, D}; pg8::StaticOrder S; S.init(NB * SEQ, D, G, bx, 128, 32); pg8::EpiResid<false> E{HB2, D, 1.0f, nullptr, nullptr, nullptr, HB1, LP, NPAD, SEQ};
        pg8::gemm_phase<pg8::EpiResid<false>, pg8::StaticOrder, true, true>(lds, g, S, E); }
    SEAM(8);
    if (IN(9)) for (int rep = 0; rep < REP[9]; ++rep) { stats_phase<false, true>(nullptr, HB1, HB2, ROWFAC, nullptr, red, bx, G, gw, NGW, wave, lane, XN8); }
    SEAM(9);
    if (IN(10)) for (int rep = 0; rep < REP[10]; ++rep) { pg8::Gemm g{(const bf16*)XN8, (const bf16*)WGU8b, M, NGU, D}; pg8::StaticOrder S; S.init(NB * SEQ, NGU, G, bx, 128, 32); pg8::EpiSwiGLU8 E{ACT, FF, ROWFAC, COLMAX2};
        pg8::gemm_phase<pg8::EpiSwiGLU8, pg8::StaticOrder, true, true, true>(lds, g, S, E);
        { const int nunits = (NB * SEQ / 256) * (NGU / 256), rounds = (nunits + G - 1) / G, nidle = rounds * G - nunits;
          if (nidle >= 8) { if (bx >= G - nidle) rows_to_int8(WD, WD8, (const unsigned*)COLMAXD2, D, FF, (bx - (G - nidle)) * NWAVES + wave, nidle * NWAVES, lane); }
          else rows_to_int8(WD, WD8, (const unsigned*)COLMAXD2, D, FF, gw, NGW, lane); }
        xcd_barrier(bar);
        act_rot_quant<true>(ACT, ACT8, ROWMAXD2, gw, NGW, lane); }
    SEAM(10);
    if (IN(11)) for (int rep = 0; rep < REP[11]; ++rep) { pg8::Gemm g{(const bf16*)ACT8, (const bf16*)WD8, M, D, FF}; pg8::StaticOrder S; S.init(NB * SEQ, D, G, bx, 128, 32); pg8::EpiResid8<false> E{HB3, D, 0.5f, nullptr, nullptr, nullptr, HB2, LP, NPAD, SEQ, ROWMAXD2, COLMAXD2, nullptr, 0};
        pg8::gemm_phase<pg8::EpiResid8<false>, pg8::StaticOrder, true, true, true>(lds, g, S, E); }
    SEAM(11);
    if (IN(12)) for (int rep = 0; rep < REP[12]; ++rep) final_phase(HB2, HB3, args.out, g_fin, nullptr, red, bx, G, gw, NGW, wave, lane);
#undef IN
#undef SEAM
}

extern "C" void kernel_launch(void* const* d_in, const int* in_sizes, int n_in, void* d_out, int out_size, void* d_ws, size_t ws_size, hipStream_t stream) {
    static int grid = 0;
    if (grid == 0) {
        if (n_in != 14 || ws_size < WS_END) { fprintf(stderr, "kernel_launch: expected 14 inputs and >= %zu bytes of workspace, got %d / %zu\n", (size_t)WS_END, n_in, ws_size); grid = -1; return; }
        int dev = 0, cus = 0, per_cu = 0;
        if (hipGetDevice(&dev) != hipSuccess || hipDeviceGetAttribute(&cus, hipDeviceAttributeMultiprocessorCount, dev) != hipSuccess) { grid = -1; return; }
        if (hipFuncSetAttribute((const void*)hybrid_fwd, hipFuncAttributeMaxDynamicSharedMemorySize, LDS_BYTES) != hipSuccess) { fprintf(stderr, "kernel_launch: hipFuncSetAttribute failed\n"); grid = -1; return; }
        if (hipOccupancyMaxActiveBlocksPerMultiprocessor(&per_cu, (const void*)hybrid_fwd, NWAVES * 64, LDS_BYTES) != hipSuccess || per_cu < 1) fprintf(stderr, "kernel_launch: occupancy query reports %d blocks per CU\n", per_cu);
        (void)hipGetLastError();
        grid = cus;
    }
    if (grid < 0) return;
    (void)hipMemsetAsync((char*)d_ws + WS_CTL, 0, CTL_ZERO_BYTES, stream);
    Args a{};
    for (int i = 0; i < 14; ++i) a.in[i] = (const float*)d_in[i];
    a.out = (float*)d_out; a.ws = (unsigned char*)d_ws;
#if MK_PER_PHASE
    for (int p = 0; p < N_PHASES; ++p) { a.ph_lo = p; a.ph_hi = p + 1; hipLaunchKernelGGL(hybrid_fwd, dim3(grid), dim3(NWAVES * 64), LDS_BYTES, stream, a); }
#else
    a.ph_lo = 0; a.ph_hi = N_PHASES; hipLaunchKernelGGL(hybrid_fwd, dim3(grid), dim3(NWAVES * 64), LDS_BYTES, stream, a);
#endif
}
```

```cpp
#include <hip/hip_runtime.h>
#include <cstdio>
#include <cstdint>
#define MK_PER_PHASE 0
namespace pg8 {
#define PG8_LAS __attribute__((address_space(3)))
typedef unsigned short bf16_t;
typedef short bf16x8 __attribute__((ext_vector_type(8)));
typedef float f32x4 __attribute__((ext_vector_type(4)));
typedef unsigned u32x4 __attribute__((ext_vector_type(4)));
typedef int i32x4 __attribute__((ext_vector_type(4)));
template <bool I8> struct AccSel { typedef f32x4 type; }; template <> struct AccSel<true> { typedef i32x4 type; };
constexpr int BM = 256, BK = 64, HALF = 128, HTB = HALF * BK * 2  , STAGE_BYTES = 8 * HTB, NXCD = 8, WGM = 8;

__host__ __device__ __forceinline__ int lds_byte(int r, int c) { const int st = (r >> 4) * 2 + (c >> 5), rr = r & 15, cc = c & 31, ob = rr * 64 + cc * 2; return st * 1024 + (ob ^ (((ob >> 9) & 1) << 5)); }
__host__ __device__ __forceinline__ void stage_rc(int b, int& R, int& C) { const int st = b / 1024, sb = b % 1024, swz = sb ^ (((sb >> 9) & 1) << 5); R = (st >> 1) * 16 + swz / 64; C = (st & 1) * 32 + (swz % 64) / 2; }
__host__ __device__ __forceinline__ int perm32(int rho) { const int n = rho >> 4, i = rho & 15; return 8 * (i >> 2) + 4 * n + (i & 3); }

struct Unit { int pm, pn, kt0, nkt, split, sl, r0; };
struct Gemm { const bf16_t* A; const bf16_t* Bt; int M, N, K; };

struct StaticOrder {
    int nM, nN, nwg, G, c, skip, grp;
    __host__ __device__ void init(int M, int N, int G_, int c_, int skip_ = 0, int grp_ = 1) { nM = M / BM; nN = N / BM; nwg = nM * nN; G = G_; c = c_; skip = skip_; grp = grp_; }
    __host__ __device__ bool next(int i, Unit& u) const {
        const long L = (long)i * G + c; if (L >= nwg) return false;
        int wgid = (int)L; { const int q = nwg / NXCD, r = nwg % NXCD, xcd = wgid % NXCD, off = wgid / NXCD; wgid = (xcd < r ? xcd * (q + 1) : r * (q + 1) + (xcd - r) * q) + off; }
        const int nig = WGM * nN, gid = wgid / nig, fm = gid * WGM, gsz = (nM - fm) < WGM ? (nM - fm) : WGM;
        u.pm = fm + ((wgid % nig) % gsz); u.pn = (wgid % nig) / gsz; u.r0 = u.pm * BM + (skip ? skip * (1 + u.pm / grp) : 0); return true;
    }
    __device__ __forceinline__ void a_ready(const Unit&) const {}
    __device__ __forceinline__ void done(const Unit&) const {}
};
struct SplitOrder {
    StaticOrder base; int G, c, nN, SL, ntp, pm_last;
    __host__ __device__ void init(int M, int N, int ntiles, int G_, int c_, int SL_) { base.init(M - BM, N, G_, c_); G = G_; c = c_; nN = N / BM; SL = SL_; ntp = ntiles / 2; pm_last = M / BM - 1; }
    __host__ __device__ bool next(int i, Unit& u) const {
        if (base.next(i, u)) return true;
        const long L = (long)i * G + c - base.nwg; if (L < 0 || L >= (long)nN * SL) return false;
        const int s = (int)(L / nN); u.pm = pm_last; u.pn = (int)(L % nN); u.r0 = pm_last * BM;
        const int p0 = (ntp * s) / SL, p1 = (ntp * (s + 1)) / SL; u.kt0 = 2 * p0; u.nkt = 2 * (p1 - p0); u.split = 1; u.sl = s; return u.nkt > 0;
    }
    __device__ __forceinline__ void a_ready(const Unit&) const {}
    __device__ __forceinline__ void done(const Unit&) const {}
};
__device__ __forceinline__ unsigned cvt_pk_bf16(float lo, float hi) { unsigned r; asm volatile("v_cvt_pk_bf16_f32 %0, %1, %2" : "=v"(r) : "v"(lo), "v"(hi)); return r; }
__device__ __forceinline__ float silu_f(float g) { return g * __builtin_amdgcn_rcpf(1.0f + __builtin_amdgcn_exp2f(-1.4426950408889634f * g)); }
template <bool HAS_RS> struct EpiSwiGLU {
    static constexpr bool PERM = true, AFTER_DRAIN = false;
    bf16_t* O; int ldc; const float* rstd;
    __device__ __forceinline__ void operator()(const f32x4 (&acc)[2][2][4][2], const Unit& u, int wr, int wc, int fr, int fq) const {
        const int row0 = u.r0 + wr * 64 + fr, col0 = u.pn * HALF + wc * 32 + 8 * fq;
        float rsv[2][4];
#pragma unroll
        for (int ai = 0; ai < 2; ++ai)
#pragma unroll
            for (int m = 0; m < 4; ++m) rsv[ai][m] = HAS_RS ? rstd[row0 + ai * HALF + m * 16] : 1.0f;
#pragma unroll
        for (int ai = 0; ai < 2; ++ai)
#pragma unroll
            for (int m = 0; m < 4; ++m) { bf16_t* rowp = O + (size_t)(row0 + ai * HALF + m * 16) * ldc + col0; const float rs = rsv[ai][m];
                const f32x4 g0 = acc[ai][0][m][0] * rs, g1 = acc[ai][0][m][1] * rs, u0 = acc[ai][1][m][0] * rs, u1 = acc[ai][1][m][1] * rs;
                float a[8];
#pragma unroll
                for (int j = 0; j < 4; ++j) { a[j] = silu_f(g0[j]) * u0[j]; a[4 + j] = silu_f(g1[j]) * u1[j]; }
                u32x4 w; w.x = cvt_pk_bf16(a[0], a[1]); w.y = cvt_pk_bf16(a[2], a[3]); w.z = cvt_pk_bf16(a[4], a[5]); w.w = cvt_pk_bf16(a[6], a[7]);
                *(u32x4*)rowp = w; }
    }
};
struct EpiSwiGLU8 {
    static constexpr bool PERM = true, AFTER_DRAIN = false;
    bf16_t* O; int ldc; const float* rowfac; const float* colmax;
    __device__ __forceinline__ void operator()(const i32x4 (&acc)[2][2][4][2], const Unit& u, int wr, int wc, int fr, int fq) const {
        const int row0 = u.r0 + wr * 64 + fr, col0 = u.pn * HALF + wc * 32 + 8 * fq, brow0 = u.pn * BM + wc * 32 + 8 * fq;
        float rsv[2][4]; f32x4 cg[2], cu[2];
#pragma unroll
        for (int ai = 0; ai < 2; ++ai)
#pragma unroll
            for (int m = 0; m < 4; ++m) rsv[ai][m] = rowfac[row0 + ai * HALF + m * 16];
#pragma unroll
        for (int n = 0; n < 2; ++n) { cg[n] = *(const f32x4*)(colmax + brow0 + 4 * n) * (1.0f / 127.0f); cu[n] = *(const f32x4*)(colmax + brow0 + HALF + 4 * n) * (1.0f / 127.0f); }
#pragma unroll
        for (int ai = 0; ai < 2; ++ai)
#pragma unroll
            for (int m = 0; m < 4; ++m) { bf16_t* rowp = O + (size_t)(row0 + ai * HALF + m * 16) * ldc + col0; const float rs = rsv[ai][m];
                const f32x4 g0 = __builtin_convertvector(acc[ai][0][m][0], f32x4) * cg[0] * rs, g1 = __builtin_convertvector(acc[ai][0][m][1], f32x4) * cg[1] * rs;
                const f32x4 u0 = __builtin_convertvector(acc[ai][1][m][0], f32x4) * cu[0] * rs, u1 = __builtin_convertvector(acc[ai][1][m][1], f32x4) * cu[1] * rs;
                float a[8];
#pragma unroll
                for (int j = 0; j < 4; ++j) { a[j] = silu_f(g0[j]) * u0[j]; a[4 + j] = silu_f(g1[j]) * u1[j]; }
                u32x4 w; w.x = cvt_pk_bf16(a[0], a[1]); w.y = cvt_pk_bf16(a[2], a[3]); w.z = cvt_pk_bf16(a[4], a[5]); w.w = cvt_pk_bf16(a[6], a[7]);
                *(u32x4*)rowp = w; }
    }
};
template <bool SRC_X> struct EpiResid {
    static constexpr bool PERM = true, AFTER_DRAIN = false;
    bf16_t* out; int ldc; float scale; float* part; const float* x0; const float* meta0; const bf16_t* src; int lp, npad, seq;
    __device__ __forceinline__ void operator()(const f32x4 (&acc)[2][2][4][2], const Unit& u, int wr, int wc, int fr, int fq) const {
        if (u.split) { store_partial(acc, u, wr, wc, fr, fq); return; }
        const int row0 = u.r0 + wr * 64 + fr, col0 = u.pn * BM + wc * 32 + 8 * fq;
#pragma unroll
        for (int ai = 0; ai < 2; ++ai)
#pragma unroll
            for (int m = 0; m < 4; ++m) { const int row = row0 + ai * HALF + m * 16; const size_t off = (size_t)row * ldc + col0;
                f32x4 h[2][2];
                if constexpr (SRC_X) { const float* srcp = x0; bool zero = false;
                    { const int b = row / lp, p = row - b * lp; if (p < npad) zero = true; else if (p < npad + 16) srcp = meta0 + (size_t)(p - npad) * ldc + col0; else srcp = x0 + ((size_t)b * seq + (size_t)(p - npad - 16)) * ldc + col0; }
#pragma unroll
                    for (int bj = 0; bj < 2; ++bj)
#pragma unroll
                        for (int n = 0; n < 2; ++n) h[bj][n] = zero ? (f32x4){0.f, 0.f, 0.f, 0.f} : *(const f32x4*)(srcp + bj * HALF + 4 * n);
                } else {
#pragma unroll
                    for (int bj = 0; bj < 2; ++bj) { const u32x4 w = *(const u32x4*)(src + off + bj * HALF);
                        h[bj][0] = (f32x4){__uint_as_float(w.x << 16), __uint_as_float(w.x & 0xffff0000u), __uint_as_float(w.y << 16), __uint_as_float(w.y & 0xffff0000u)};
                        h[bj][1] = (f32x4){__uint_as_float(w.z << 16), __uint_as_float(w.z & 0xffff0000u), __uint_as_float(w.w << 16), __uint_as_float(w.w & 0xffff0000u)}; }
                }
#pragma unroll
                for (int bj = 0; bj < 2; ++bj) { const f32x4 a0 = h[bj][0] + acc[ai][bj][m][0] * scale, a1 = h[bj][1] + acc[ai][bj][m][1] * scale;
                    u32x4 w; w.x = cvt_pk_bf16(a0[0], a0[1]); w.y = cvt_pk_bf16(a0[2], a0[3]); w.z = cvt_pk_bf16(a1[0], a1[1]); w.w = cvt_pk_bf16(a1[2], a1[3]);
                    *(u32x4*)(out + off + bj * HALF) = w; }
                asm volatile("" ::: "memory"); }
    }
    __device__ __forceinline__ void store_partial(const f32x4 (&acc)[2][2][4][2], const Unit& u, int wr, int wc, int fr, int fq) const {
        const int row0 = wr * 64 + fr, col0 = u.pn * BM + wc * 32 + 8 * fq; float* base = part + (size_t)u.sl * BM * ldc;
#pragma unroll
        for (int ai = 0; ai < 2; ++ai)
#pragma unroll
            for (int m = 0; m < 4; ++m) { float* rowp = base + (size_t)(row0 + ai * HALF + m * 16) * ldc + col0;
#pragma unroll
                for (int bj = 0; bj < 2; ++bj)
#pragma unroll
                    for (int n = 0; n < 2; ++n) *(f32x4*)(rowp + bj * HALF + 4 * n) = acc[ai][bj][m][n] * scale; }
    }
};
template <bool SRC_X> struct EpiResid8 {
    static constexpr bool PERM = true, AFTER_DRAIN = false;
    bf16_t* out; int ldc; float scale; float* part; const float* x0; const float* meta0; const bf16_t* src; int lp, npad, seq; const unsigned* rowmax; const float* colmax;
    float* sq; int sqld;
    __device__ __forceinline__ void operator()(const i32x4 (&acc)[2][2][4][2], const Unit& u, int wr, int wc, int fr, int fq) const {
        const int row0 = u.r0 + wr * 64 + fr, col0 = u.pn * BM + wc * 32 + 8 * fq;
        f32x4 cf[2][2]; float rf[2][4];
#pragma unroll
        for (int bj = 0; bj < 2; ++bj)
#pragma unroll
            for (int n = 0; n < 2; ++n) cf[bj][n] = *(const f32x4*)(colmax + col0 + bj * HALF + 4 * n) * (scale * (1.0f / (127.0f * 127.0f)));
#pragma unroll
        for (int ai = 0; ai < 2; ++ai)
#pragma unroll
            for (int m = 0; m < 4; ++m) rf[ai][m] = __uint_as_float(rowmax[row0 + ai * HALF + m * 16]);
        if (u.split) {
            const int prow0 = wr * 64 + fr; float* base = part + (size_t)u.sl * BM * ldc;
#pragma unroll
            for (int ai = 0; ai < 2; ++ai)
#pragma unroll
                for (int m = 0; m < 4; ++m) { float* rowp = base + (size_t)(prow0 + ai * HALF + m * 16) * ldc + col0;
#pragma unroll
                    for (int bj = 0; bj < 2; ++bj)
#pragma unroll
                        for (int n = 0; n < 2; ++n) *(f32x4*)(rowp + bj * HALF + 4 * n) = __builtin_convertvector(acc[ai][bj][m][n], f32x4) * cf[bj][n] * rf[ai][m]; }
            return; }
#pragma unroll
        for (int ai = 0; ai < 2; ++ai)
#pragma unroll
            for (int m = 0; m < 4; ++m) { const int row = row0 + ai * HALF + m * 16; const size_t off = (size_t)row * ldc + col0;
                f32x4 h[2][2];
                if constexpr (SRC_X) { const float* srcp = x0; bool zero = false;
                    { const int b = row / lp, p = row - b * lp; if (p < npad) zero = true; else if (p < npad + 16) srcp = meta0 + (size_t)(p - npad) * ldc + col0; else srcp = x0 + ((size_t)b * seq + (size_t)(p - npad - 16)) * ldc + col0; }
#pragma unroll
                    for (int bj = 0; bj < 2; ++bj)
#pragma unroll
                        for (int n = 0; n < 2; ++n) h[bj][n] = zero ? (f32x4){0.f, 0.f, 0.f, 0.f} : *(const f32x4*)(srcp + bj * HALF + 4 * n);
                } else {
#pragma unroll
                    for (int bj = 0; bj < 2; ++bj) { const u32x4 w = *(const u32x4*)(src + off + bj * HALF);
                        h[bj][0] = (f32x4){__uint_as_float(w.x << 16), __uint_as_float(w.x & 0xffff0000u), __uint_as_float(w.y << 16), __uint_as_float(w.y & 0xffff0000u)};
                        h[bj][1] = (f32x4){__uint_as_float(w.z << 16), __uint_as_float(w.z & 0xffff0000u), __uint_as_float(w.w << 16), __uint_as_float(w.w & 0xffff0000u)}; }
                }
                float ss = 0.f;
#pragma unroll
                for (int bj = 0; bj < 2; ++bj) { const f32x4 a0 = h[bj][0] + __builtin_convertvector(acc[ai][bj][m][0], f32x4) * cf[bj][0] * rf[ai][m], a1 = h[bj][1] + __builtin_convertvector(acc[ai][bj][m][1], f32x4) * cf[bj][1] * rf[ai][m];
                    u32x4 w; w.x = cvt_pk_bf16(a0[0], a0[1]); w.y = cvt_pk_bf16(a0[2], a0[3]); w.z = cvt_pk_bf16(a1[0], a1[1]); w.w = cvt_pk_bf16(a1[2], a1[3]);
                    *(u32x4*)(out + off + bj * HALF) = w;
                    if (sq) ss += ((a0[0] * a0[0] + a0[1] * a0[1]) + (a0[2] * a0[2] + a0[3] * a0[3])) + ((a1[0] * a1[0] + a1[1] * a1[1]) + (a1[2] * a1[2] + a1[3] * a1[3])); }
                if (sq) { ss += __shfl_xor(ss, 16); ss += __shfl_xor(ss, 32); if (fq == 0) sq[(size_t)(4 * u.pn + wc) * sqld + row] = ss; }
                asm volatile("" ::: "memory"); }
    }
};
struct EpiProj {
    static constexpr bool PERM = true, AFTER_DRAIN = false;
    bf16_t* O; int ldc; const float* bias; int lp, npad; const float* rstd;
    __device__ __forceinline__ void operator()(const f32x4 (&acc)[2][2][4][2], const Unit& u, int wr, int wc, int fr, int fq) const {
        const int row0 = u.r0 + wr * 64 + fr, col0 = u.pn * BM + wc * 32 + 8 * fq;
        f32x4 bv[2][2];
#pragma unroll
        for (int bj = 0; bj < 2; ++bj)
#pragma unroll
            for (int n = 0; n < 2; ++n) bv[bj][n] = *(const f32x4*)(bias + col0 + bj * HALF + 4 * n);
        float rsv[2][4];
#pragma unroll
        for (int ai = 0; ai < 2; ++ai)
#pragma unroll
            for (int m = 0; m < 4; ++m) rsv[ai][m] = rstd[row0 + ai * HALF + m * 16];
#pragma unroll
        for (int ai = 0; ai < 2; ++ai)
#pragma unroll
            for (int m = 0; m < 4; ++m) { const int row = row0 + ai * HALF + m * 16; bf16_t* rowp = O + (size_t)row * ldc + col0;
                const bool pad = (row % lp) < npad; const float rs = rsv[ai][m];
#pragma unroll
                for (int bj = 0; bj < 2; ++bj) { const f32x4 v0 = acc[ai][bj][m][0] * rs + bv[bj][0], v1 = acc[ai][bj][m][1] * rs + bv[bj][1];
                    u32x4 w; w.x = cvt_pk_bf16(v0[0], v0[1]); w.y = cvt_pk_bf16(v0[2], v0[3]); w.z = cvt_pk_bf16(v1[0], v1[1]); w.w = cvt_pk_bf16(v1[2], v1[3]);
                    if (pad) w = (u32x4){0u, 0u, 0u, 0u};
                    *(u32x4*)(rowp + bj * HALF) = w; } }
    }
};
template <bool I8> __device__ __forceinline__ typename AccSel<I8>::type mma16(bf16x8 a, bf16x8 b, typename AccSel<I8>::type c) {
    if constexpr (I8) return __builtin_amdgcn_mfma_i32_16x16x64_i8(__builtin_bit_cast(i32x4, a), __builtin_bit_cast(i32x4, b), c, 0, 0, 0);
    else return __builtin_amdgcn_mfma_f32_16x16x32_bf16(a, b, c, 0, 0, 0);
}
template <class Epi, class Sched, bool ALIGN_EPI = false, bool SP2 = false, bool I8 = false>
__device__ __forceinline__ void gemm_phase(PG8_LAS unsigned char* lds, const Gemm g, const Sched& S, const Epi& E) {
    const int tid = threadIdx.x, wid = __builtin_amdgcn_readfirstlane(tid >> 6), lane = tid & 63, wr = wid >> 2, wc = wid & 3, fr = lane & 15, fq = lane >> 4;
    const int K = g.K, RB = I8 ? K : 2 * K  , nt = RB / (2 * BK);
    unsigned voffA[2], voffB[2];
#pragma unroll
    for (int i = 0; i < 2; ++i) { int R, C; stage_rc(tid * 16 + i * 8192, R, C); const int Rb = Epi::PERM ? ((R & ~31) + perm32(R & 31)) : R;
        voffA[i] = (unsigned)(R * RB + 2 * C); voffB[i] = (unsigned)(Rb * RB + 2 * C); }
    const size_t kstep = (size_t)(BK * 2);
    const size_t hstep = (size_t)HALF * RB;
    const size_t tstep = 2 * hstep;
    const unsigned ldsw = (unsigned)wid * 1024u;
    const int aoff = lds_byte(wr * 64 + fr, fq * 8), boff = lds_byte(wc * 32 + fr, fq * 8);
#define PG8_SA(b, h) (((b) * 2 + (h)) * HTB)
#define PG8_SB(b, h) ((4 + (b) * 2 + (h)) * HTB)
#define PG8_STAGE(bufoff, gbase, voff) do { _Pragma("unroll") for (int _i = 0; _i < 2; ++_i) \
        __builtin_amdgcn_global_load_lds((const unsigned*)((const char*)(gbase) + (voff)[_i]), (PG8_LAS unsigned*)(lds + (bufoff) + ldsw + _i * 8192), 16, 0, 0); } while (0)
#define PG8_LDA(dst, b, h) do { _Pragma("unroll") for (int m = 0; m < 4; ++m) _Pragma("unroll") for (int k = 0; k < 2; ++k) dst[m][k] = *(const PG8_LAS bf16x8*)(lds + PG8_SA(b, h) + aoff + m * 2048 + k * 1024); } while (0)
#define PG8_LDB(dst, b, h) do { _Pragma("unroll") for (int n = 0; n < 2; ++n) _Pragma("unroll") for (int k = 0; k < 2; ++k) dst[n][k] = *(const PG8_LAS bf16x8*)(lds + PG8_SB(b, h) + boff + n * 2048 + k * 1024); } while (0)
#define PG8_MMA(ai, bj, At, Bt) do { __builtin_amdgcn_s_setprio(1); asm volatile(".p2align 3"); _Pragma("unroll") for (int m = 0; m < 4; ++m) _Pragma("unroll") for (int n = 0; n < 2; ++n) _Pragma("unroll") for (int k = 0; k < 2; ++k) \
        acc[ai][bj][m][n] = mma16<I8>(Bt[n][k], At[m][k], acc[ai][bj][m][n]); __builtin_amdgcn_s_setprio(0); } while (0)
#define PG8_WAIT_V(n) asm volatile("s_waitcnt vmcnt(" #n ")" ::: "memory")
#define PG8_WAIT_L(n) asm volatile("s_waitcnt lgkmcnt(" #n ")" ::: "memory")
#define PG8_BAR __builtin_amdgcn_s_barrier()
#define PG8_SCHED __builtin_amdgcn_sched_barrier(0)
    Unit cur, nxt; int ui = 0;
    cur.kt0 = 0; cur.nkt = nt; cur.split = 0; cur.sl = 0;
    if (!S.next(0, cur)) return;
    typedef typename AccSel<I8>::type acc_t; const acc_t acc_zero = {};
    acc_t acc[2][2][4][2];
#pragma unroll
    for (int a = 0; a < 2; ++a)
#pragma unroll
        for (int b = 0; b < 2; ++b)
#pragma unroll
            for (int m = 0; m < 4; ++m)
#pragma unroll
                for (int n = 0; n < 2; ++n) acc[a][b][m][n] = acc_zero;
    bf16x8 At[4][2], B0[2][2], B1[2][2];
    const char* cA = (const char*)g.A + (size_t)cur.r0 * RB + (size_t)cur.kt0 * kstep; const char* cB = (const char*)g.Bt + (size_t)cur.pn * tstep + (size_t)cur.kt0 * kstep;
    S.a_ready(cur);
    if constexpr (SP2) {
        PG8_STAGE(PG8_SB(0, 0), cB, voffB); PG8_STAGE(PG8_SB(0, 1), cB + hstep, voffB); PG8_STAGE(PG8_SA(0, 0), cA, voffA); PG8_STAGE(PG8_SA(0, 1), cA + hstep, voffA);
        if (wr == 1) PG8_BAR;
        PG8_WAIT_V(2); PG8_BAR;
        PG8_STAGE(PG8_SB(1, 0), cB + kstep, voffB); PG8_STAGE(PG8_SA(1, 0), cA + kstep, voffA); PG8_STAGE(PG8_SB(1, 1), cB + hstep + kstep, voffB);
        PG8_WAIT_V(6); PG8_BAR;
    } else {
        PG8_STAGE(PG8_SB(0, 0), cB, voffB); PG8_STAGE(PG8_SA(0, 0), cA, voffA); PG8_STAGE(PG8_SB(0, 1), cB + hstep, voffB); PG8_STAGE(PG8_SA(0, 1), cA + hstep, voffA);
        if (wr == 1) PG8_BAR;
        PG8_WAIT_V(4); PG8_BAR;
        PG8_STAGE(PG8_SB(1, 0), cB + kstep, voffB); PG8_STAGE(PG8_SA(1, 0), cA + kstep, voffA); PG8_STAGE(PG8_SB(1, 1), cB + hstep + kstep, voffB);
        PG8_WAIT_V(6); PG8_BAR;
    }
    for (;;) {
        nxt.kt0 = 0; nxt.nkt = nt; nxt.split = 0; nxt.sl = 0;
        const bool has_next = S.next(ui + 1, nxt);
        const int cnt = cur.nkt;
        const char* nA = has_next ? (const char*)g.A + (size_t)nxt.r0 * RB + (size_t)nxt.kt0 * kstep : cA; const char* nB = has_next ? (const char*)g.Bt + (size_t)nxt.pn * tstep + (size_t)nxt.kt0 * kstep : cB;
        for (int t = 0; t < cnt; t += 2) {
            const bool last = (t == cnt - 2);
            const char* a1 = cA + (size_t)(t + 1) * kstep;
            const char* a2 = last ? nA : cA + (size_t)(t + 2) * kstep; const char* b2 = last ? nB : cB + (size_t)(t + 2) * kstep;
            const char* a3 = a2 + kstep; const char* b3 = b2 + kstep;
            if (last && has_next) S.a_ready(nxt);
            if constexpr (SP2) {
            PG8_LDB(B0, 0, 0); PG8_LDB(B1, 0, 1); PG8_SCHED; PG8_LDA(At, 0, 0); PG8_STAGE(PG8_SA(1, 1), a1 + hstep, voffA);
            PG8_WAIT_V(8); PG8_WAIT_L(0); PG8_BAR; PG8_MMA(0, 0, At, B0); PG8_MMA(0, 1, At, B1); PG8_BAR; PG8_SCHED;
            PG8_LDA(At, 0, 1); PG8_STAGE(PG8_SB(0, 0), b2, voffB); PG8_STAGE(PG8_SB(0, 1), b2 + hstep, voffB); PG8_STAGE(PG8_SA(0, 0), a2, voffA);
            PG8_WAIT_V(8); PG8_WAIT_L(0); PG8_BAR; PG8_MMA(1, 0, At, B0); PG8_MMA(1, 1, At, B1); PG8_BAR; PG8_SCHED;
            PG8_LDB(B0, 1, 0); PG8_LDB(B1, 1, 1); PG8_SCHED; PG8_LDA(At, 1, 0); PG8_STAGE(PG8_SA(0, 1), a2 + hstep, voffA);
            PG8_WAIT_V(8); PG8_WAIT_L(0); PG8_BAR; PG8_MMA(0, 0, At, B0); PG8_MMA(0, 1, At, B1); PG8_BAR; PG8_SCHED;
            PG8_LDA(At, 1, 1); PG8_STAGE(PG8_SB(1, 0), b3, voffB); PG8_STAGE(PG8_SB(1, 1), b3 + hstep, voffB); PG8_STAGE(PG8_SA(1, 0), a3, voffA);
            PG8_WAIT_V(8); PG8_WAIT_L(0); PG8_BAR; PG8_MMA(1, 0, At, B0); PG8_MMA(1, 1, At, B1); PG8_BAR; PG8_SCHED;
            } else {
            PG8_LDB(B0, 0, 0); PG8_SCHED; PG8_LDA(At, 0, 0); PG8_STAGE(PG8_SA(1, 1), a1 + hstep, voffA);
            PG8_WAIT_L(8); PG8_BAR; PG8_WAIT_L(0); PG8_MMA(0, 0, At, B0); PG8_BAR; PG8_SCHED;
            PG8_LDB(B1, 0, 1); PG8_STAGE(PG8_SB(0, 0), b2, voffB);
            PG8_BAR; PG8_WAIT_L(0); PG8_MMA(0, 1, At, B1); PG8_BAR;
            PG8_LDA(At, 0, 1); PG8_STAGE(PG8_SA(0, 0), a2, voffA);
            PG8_BAR; PG8_WAIT_L(0); PG8_MMA(1, 0, At, B0); PG8_BAR; PG8_SCHED;
            PG8_STAGE(PG8_SB(0, 1), b2 + hstep, voffB);
            PG8_WAIT_V(6); PG8_BAR; PG8_MMA(1, 1, At, B1); PG8_BAR;
            PG8_LDB(B0, 1, 0); PG8_SCHED; PG8_LDA(At, 1, 0); PG8_STAGE(PG8_SA(0, 1), a2 + hstep, voffA);
            PG8_WAIT_L(8); PG8_BAR; PG8_WAIT_L(0); PG8_MMA(0, 0, At, B0); PG8_BAR; PG8_SCHED;
            PG8_LDB(B1, 1, 1); PG8_STAGE(PG8_SB(1, 0), b3, voffB);
            PG8_BAR; PG8_WAIT_L(0); PG8_MMA(0, 1, At, B1); PG8_BAR;
            PG8_LDA(At, 1, 1); PG8_STAGE(PG8_SA(1, 0), a3, voffA);
            PG8_BAR; PG8_WAIT_L(0); PG8_MMA(1, 0, At, B0); PG8_BAR; PG8_SCHED;
            PG8_STAGE(PG8_SB(1, 1), b3 + hstep, voffB);
            PG8_WAIT_V(6); PG8_BAR; PG8_MMA(1, 1, At, B1); PG8_BAR;
            }
        }
        if constexpr (ALIGN_EPI) { if (wr == 0) PG8_BAR; }
        if constexpr (!Epi::AFTER_DRAIN) { E(acc, cur, wr, wc, fr, fq); S.done(cur); }
        if (!has_next) break;
#pragma unroll
        for (int a = 0; a < 2; ++a)
#pragma unroll
            for (int b = 0; b < 2; ++b)
#pragma unroll
                for (int m = 0; m < 4; ++m)
#pragma unroll
                    for (int n = 0; n < 2; ++n) acc[a][b][m][n] = acc_zero;
        cur = nxt; cA = nA; cB = nB; ++ui;
        if constexpr (ALIGN_EPI) { if (wr == 1) PG8_BAR; }
    }
    PG8_WAIT_V(0);
    if constexpr (!ALIGN_EPI) { if (wr == 0) PG8_BAR; }
    PG8_BAR;
    if constexpr (Epi::AFTER_DRAIN) { E.fused(acc, cur, wr, wc, fr, fq, lds, wid, lane); S.done(cur); }
#undef PG8_SA
#undef PG8_SB
#undef PG8_STAGE
#undef PG8_LDA
#undef PG8_LDB
#undef PG8_MMA
#undef PG8_WAIT_V
#undef PG8_WAIT_L
#undef PG8_BAR
#undef PG8_SCHED
}
}
#ifndef MK_PER_PHASE
#define MK_PER_PHASE 0
#endif
constexpr int NWAVES = 8;
constexpr int D = 4096, SEQ = 8192, NB = 2, LP = 8320, NCH = 65, NPAD = 112, M = NB * LP;
constexpr int FF = 11008, NGU = 2 * FF, INW = 10752;
constexpr int OFF_QA = 0, OFF_KA = 2048, OFF_VA = 2304, OFF_QR = 2560, OFF_KR = 4608, OFF_VR = 6656, OFF_GR = 8704;
constexpr float EPS = 1e-6f, LOG2E = 1.4426950408889634f;
static_assert(M % 256 == 0 && NGU % 256 == 0 && INW % 256 == 0 && FF % 128 == 0, "GEMM tiling");

constexpr size_t MiB = 1u << 20;
constexpr size_t WS_CTL = 0, CTL_ZERO_BYTES = 1 * MiB;
constexpr size_t WS_H = 1 * MiB;
constexpr size_t WS_XN = 261 * MiB;
constexpr size_t WS_ACT = 563 * MiB;
constexpr size_t WS_WGU = 391 * MiB;
constexpr size_t WS_WD = 913 * MiB;
constexpr size_t WS_WIN = 999 * MiB;
constexpr size_t WS_WOUT = 1083 * MiB;
constexpr size_t WS_ST = 1115 * MiB;
constexpr size_t WS_HB2 = 1245 * MiB;
constexpr size_t WS_WD8 = 1375 * MiB;
constexpr size_t WS_END = 1418 * MiB;
constexpr size_t WS_RSTD = 512 * 1024;
constexpr size_t WS_ROWFAC = 580 * 1024;
constexpr size_t WS_ROWMAXD1 = 824 * 1024, WS_ROWMAXD2 = 890 * 1024, WS_COLMAXD1 = 956 * 1024, WS_COLMAXD2 = 972 * 1024;
constexpr size_t WS_COLMAX1 = 648 * 1024, WS_COLMAX2 = 736 * 1024;
constexpr int CW_BAR = 4096;
static_assert(WS_ROWFAC >= WS_RSTD + (size_t)M * 4 && WS_COLMAX1 >= WS_ROWFAC + (size_t)M * 4 && WS_COLMAX2 >= WS_COLMAX1 + (size_t)NGU * 4 && WS_COLMAX2 + (size_t)NGU * 4 <= CTL_ZERO_BYTES, "control region map");


constexpr int SCR_BYTES = 143360;
constexpr int MISC_OFF = SCR_BYTES;
constexpr int LDS_BYTES = 147456;

#define GAS __attribute__((address_space(1)))
#define LAS __attribute__((address_space(3)))
typedef unsigned short bf16;
typedef unsigned v4u __attribute__((ext_vector_type(4)));
typedef unsigned v2u __attribute__((ext_vector_type(2)));
typedef float f32x4 __attribute__((ext_vector_type(4)));
typedef short bf16x8 __attribute__((ext_vector_type(8)));
typedef short s16x4 __attribute__((ext_vector_type(4)));
#define LDS_WAIT() asm volatile("s_waitcnt lgkmcnt(0)" ::: "memory")
#define MFMA16(a, b, c) __builtin_amdgcn_mfma_f32_16x16x32_bf16((a), (b), (c), 0, 0, 0)
__device__ __forceinline__ float bf2f(unsigned b16) { return __uint_as_float(b16 << 16); }
typedef float f32x2_t __attribute__((ext_vector_type(2))); typedef __bf16 bf16x2_t __attribute__((ext_vector_type(2)));
__device__ __forceinline__ unsigned pk2(float lo, float hi) { const f32x2_t v = {lo, hi}; return __builtin_bit_cast(unsigned, __builtin_convertvector(v, bf16x2_t)); }
__device__ __forceinline__ float wave_sum(float v) {
#pragma unroll
    for (int o = 1; o < 64; o <<= 1) v += __shfl_xor(v, o);
    return v;
}
__device__ __forceinline__ s16x4 ds_tr16(const LAS unsigned char* p) { return __builtin_bit_cast(s16x4, __builtin_amdgcn_ds_read_tr16_b64_v4i16((LAS s16x4*)p)); }
__device__ __forceinline__ bf16x8 cat8(s16x4 lo, s16x4 hi) { return (bf16x8){lo[0], lo[1], lo[2], lo[3], hi[0], hi[1], hi[2], hi[3]}; }
__device__ __forceinline__ float log2_gamma(int h) { return log1pf(-exp2f(-5.0f - (float)h)) * LOG2E; }

#define XB_TMO      128
#define XB_XCNT(j)  (256  + 64 * (j))
#define XB_XSUB(j)  (1280 + 64 * (j))
#define XB_XGEN(j)  (2304 + 64 * (j))
#define XB_TOP      3328
#define XB_TOPGEN   3392
#define XCD_BAR_WORDS 3456
#define XB_SPIN_CAP (1u << 18)

__device__ __forceinline__ unsigned xb_ld(unsigned* p)              { return __hip_atomic_load(p, __ATOMIC_RELAXED, __HIP_MEMORY_SCOPE_AGENT); }
__device__ __forceinline__ unsigned xb_add(unsigned* p, unsigned v) { return __hip_atomic_fetch_add(p, v, __ATOMIC_RELAXED, __HIP_MEMORY_SCOPE_AGENT); }
__device__ __forceinline__ unsigned xb_xcc_id() { return (unsigned)__builtin_amdgcn_s_getreg((3 << 11) | 20) & 0xFu; }
#define XB_SPIN(cond, bar) do { unsigned _sp = 0; while (cond) { __builtin_amdgcn_s_sleep(1); \
    if ((++_sp & 255u) == 0u) { if (xb_ld(&(bar)[XB_TMO])) break; if (_sp > XB_SPIN_CAP) { atomicAdd(&(bar)[XB_TMO], 1u); break; } } } } while (0)

struct XcdBarrier {
    unsigned* bar; unsigned x;
    volatile LAS unsigned* st;
};

__device__ __forceinline__ XcdBarrier xcd_barrier_post(unsigned* bar, volatile LAS unsigned* st) {
    XcdBarrier b; b.bar = bar; b.x = xb_xcc_id(); b.st = st;
    if (threadIdx.x == 0) (void)xb_add(&bar[XB_XCNT(b.x)], 1u);
    return b;
}
__device__ __forceinline__ void xcd_barrier_complete(unsigned* bar, unsigned x, unsigned& nloc, unsigned& nx) {
    const unsigned G = gridDim.x * gridDim.y * gridDim.z;
    unsigned sum, cnt, mine, sp = 0u;
    for (;;) {
        sum = 0u; cnt = 0u; mine = 0u;
#pragma unroll
        for (unsigned j = 0; j < 16; ++j) { const unsigned c = xb_ld(&bar[XB_XCNT(j)]); sum += c; cnt += (c > 0u) ? 1u : 0u; mine = (j == x) ? c : mine; }
        if (sum == G) break;
        __builtin_amdgcn_s_sleep(1);
        if ((++sp & 255u) == 0u) { if (xb_ld(&bar[XB_TMO])) break; if (sp > XB_SPIN_CAP) { atomicAdd(&bar[XB_TMO], 1u); break; } }
    }
    nloc = mine > 0u ? mine : 1u; nx = cnt > 0u ? cnt : 1u;
}

__device__ __forceinline__ void xcd_barrier(const XcdBarrier& b) {
    asm volatile("s_waitcnt vmcnt(0)" ::: "memory");
    __syncthreads();
    if (threadIdx.x == 0) {
        unsigned* bar = b.bar;
        __builtin_amdgcn_s_waitcnt(0);
        unsigned nloc = b.st[0], nx = b.st[1];
        if (nloc == 0u) { xcd_barrier_complete(bar, b.x, nloc, nx); b.st[0] = nloc; b.st[1] = nx; }
        const unsigned old = xb_add(&bar[XB_XSUB(b.x)], 1u);
        const unsigned gen = old / nloc;
        if (old + 1u == (gen + 1u) * nloc) {
            __builtin_amdgcn_fence(__ATOMIC_RELEASE, "agent");
            asm volatile("s_waitcnt vmcnt(0)" ::: "memory");
            const unsigned og = xb_add(&bar[XB_TOP], 1u);
            const unsigned tg = og / nx;
            if (og + 1u == (tg + 1u) * nx) xb_add(&bar[XB_TOPGEN], 1u);
            else XB_SPIN(xb_ld(&bar[XB_TOPGEN]) == tg, bar);
            __builtin_amdgcn_fence(__ATOMIC_ACQUIRE, "agent");
            xb_add(&bar[XB_XGEN(b.x)], 1u);
            asm volatile("s_waitcnt vmcnt(0)" ::: "memory");
        } else {
            XB_SPIN(xb_ld(&bar[XB_XGEN(b.x)]) == gen, bar);
            __builtin_amdgcn_fence(__ATOMIC_ACQUIRE, "agent");
            asm volatile("s_waitcnt vmcnt(0)" ::: "memory");
        }
    }
    __syncthreads();
}


__device__ __forceinline__ void rows_init(const float* x, const float* meta, bf16* HB, float* rstd, int gw, int NGW, int lane) {
    for (int r = gw; r < M; r += NGW) {
        const int b = r / LP, p = r - b * LP;
        const bool zero = p < NPAD; const float* src = (p < 128) ? meta + (size_t)(zero ? 0 : p - NPAD) * D : x + ((size_t)b * SEQ + (size_t)(p - 128)) * D;
        f32x4 v[16]; float ss = 0.f;
#pragma unroll
        for (int j = 0; j < 16; ++j) { v[j] = zero ? (f32x4){0.f, 0.f, 0.f, 0.f} : ((const f32x4*)src)[lane + 64 * j]; ss += (v[j].x * v[j].x + v[j].y * v[j].y) + (v[j].z * v[j].z + v[j].w * v[j].w); }
        ss = wave_sum(ss);
        const float rs = 1.0f / sqrtf(ss * (1.0f / D) + EPS);
#pragma unroll
        for (int j = 0; j < 16; ++j) { const f32x4 y = v[j] * rs; v2u w; w.x = pk2(y.x, y.y); w.y = pk2(y.z, y.w); ((v2u*)(HB + (size_t)r * D))[lane + 64 * j] = w; }
    }
}
__device__ __forceinline__ f32x4 bf4_to_f32(v2u w) { return (f32x4){__uint_as_float(w.x << 16), __uint_as_float(w.x & 0xffff0000u), __uint_as_float(w.y << 16), __uint_as_float(w.y & 0xffff0000u)}; }
constexpr int NSL_D1 = 3;
constexpr float P2_TAIL_FRAC = 0.85f;
template <bool FROM_X, bool Q8 = false>
__device__ __forceinline__ void stats_phase(const float* x, const bf16* Hprev, bf16* HB, float* rstd, const float* part, LAS float* red, int bx, int G, int gw, int NGW, int wave, int lane, unsigned char* A8 = nullptr, const float* sq = nullptr) {
    if (part) for (int hr = bx; hr < 256; hr += G) {
        const int r = M - 256 + hr, b = r / LP, p = r - b * LP;
        f32x4 v[2]; float ss = 0.f, am = 0.f;
#pragma unroll
        for (int j = 0; j < 2; ++j) { const size_t c = (size_t)(512 * wave + 256 * j + 4 * lane);
            v[j] = FROM_X ? *(const f32x4*)(x + ((size_t)b * SEQ + (size_t)(p - 128)) * D + c) : bf4_to_f32(*(const v2u*)(Hprev + (size_t)r * D + c));
#pragma unroll
            for (int s = 0; s < NSL_D1; ++s) v[j] = v[j] + *(const f32x4*)(part + ((size_t)s * 256 + hr) * D + c);
            { v2u w; w.x = pk2(v[j].x, v[j].y); w.y = pk2(v[j].z, v[j].w); *(v2u*)(HB + (size_t)r * D + c) = w; }
            ss += (v[j].x * v[j].x + v[j].y * v[j].y) + (v[j].z * v[j].z + v[j].w * v[j].w);
            am = fmaxf(fmaxf(am, fmaxf(fabsf(v[j].x), fabsf(v[j].y))), fmaxf(fabsf(v[j].z), fabsf(v[j].w))); }
        ss = wave_sum(ss);
#pragma unroll
        for (int o = 1; o < 64; o <<= 1) am = fmaxf(am, __shfl_xor(am, o));
        if (lane == 0) { red[wave] = ss; red[NWAVES + wave] = am; }
        __syncthreads();
        float tot = 0.f, amt = 0.f;
#pragma unroll
        for (int w = 0; w < NWAVES; ++w) { tot += red[w]; amt = fmaxf(amt, red[NWAVES + w]); }
        __syncthreads();
        const float rs = 1.0f / sqrtf(tot * (1.0f / D) + EPS);
        if (!Q8) { if (wave == 0 && lane == 0) rstd[r] = rs; }
        else { const float inv = amt > 0.f ? 127.0f / amt : 0.f; if (wave == 0 && lane == 0) rstd[r] = rs * amt * (1.0f / 127.0f);
#pragma unroll
            for (int j = 0; j < 2; ++j) { const size_t c = (size_t)(512 * wave + 256 * j + 4 * lane);
                const int b0 = (int)rintf(v[j].x * inv), b1 = (int)rintf(v[j].y * inv), b2 = (int)rintf(v[j].z * inv), b3 = (int)rintf(v[j].w * inv);
                *(unsigned*)(A8 + (size_t)r * D + c) = (unsigned)(b0 & 0xff) | ((unsigned)(b1 & 0xff) << 8) | ((unsigned)(b2 & 0xff) << 16) | ((unsigned)(b3 & 0xff) << 24); } }
    }
    if (!Q8 && sq) {
        for (int r = gw * 64 + lane; r < M - 256; r += NGW * 64) { float s = 0.f;
#pragma unroll 16
            for (int t = 0; t < 64; ++t) s += sq[(size_t)t * M + r];
            rstd[r] = 1.0f / sqrtf(s * (1.0f / D) + EPS); }
        return; }
    for (int r = gw; r < (part ? M - 256 : M); r += NGW) {
        if (!part && (r % LP) < 128) continue;
        float ss = 0.f, am = 0.f; v4u wq[8];
#pragma unroll
        for (int j = 0; j < 8; ++j) { const v4u w = ((const v4u*)(HB + (size_t)r * D))[lane + 64 * j]; wq[j] = w;
            const float a0 = bf2f(w.x & 0xffffu), a1 = bf2f(w.x >> 16), a2 = bf2f(w.y & 0xffffu), a3 = bf2f(w.y >> 16), a4 = bf2f(w.z & 0xffffu), a5 = bf2f(w.z >> 16), a6 = bf2f(w.w & 0xffffu), a7 = bf2f(w.w >> 16);
            ss += ((a0 * a0 + a1 * a1) + (a2 * a2 + a3 * a3)) + ((a4 * a4 + a5 * a5) + (a6 * a6 + a7 * a7));
            if (Q8) am = fmaxf(fmaxf(fmaxf(am, fmaxf(fabsf(a0), fabsf(a1))), fmaxf(fabsf(a2), fabsf(a3))), fmaxf(fmaxf(fabsf(a4), fabsf(a5)), fmaxf(fabsf(a6), fabsf(a7)))); }
        ss = wave_sum(ss);
        const float rs = 1.0f / sqrtf(ss * (1.0f / D) + EPS);
        if (!Q8) { if (lane == 0) rstd[r] = rs; }
        else {
#pragma unroll
            for (int o = 1; o < 64; o <<= 1) am = fmaxf(am, __shfl_xor(am, o));
            const float inv = am > 0.f ? 127.0f / am : 0.f; if (lane == 0) rstd[r] = rs * am * (1.0f / 127.0f);
#pragma unroll
            for (int j = 0; j < 8; ++j) { const v4u w = wq[j]; unsigned lo, hi;
                { const int b0 = (int)rintf(bf2f(w.x & 0xffffu) * inv), b1 = (int)rintf(bf2f(w.x >> 16) * inv), b2 = (int)rintf(bf2f(w.y & 0xffffu) * inv), b3 = (int)rintf(bf2f(w.y >> 16) * inv);
                  lo = (unsigned)(b0 & 0xff) | ((unsigned)(b1 & 0xff) << 8) | ((unsigned)(b2 & 0xff) << 16) | ((unsigned)(b3 & 0xff) << 24); }
                { const int b0 = (int)rintf(bf2f(w.z & 0xffffu) * inv), b1 = (int)rintf(bf2f(w.z >> 16) * inv), b2 = (int)rintf(bf2f(w.w & 0xffffu) * inv), b3 = (int)rintf(bf2f(w.w >> 16) * inv);
                  hi = (unsigned)(b0 & 0xff) | ((unsigned)(b1 & 0xff) << 8) | ((unsigned)(b2 & 0xff) << 16) | ((unsigned)(b3 & 0xff) << 24); }
                ((v2u*)(A8 + (size_t)r * D))[lane + 64 * j] = (v2u){lo, hi}; }
        }
    }
}
__device__ __forceinline__ void final_phase(const bf16* Hprev, const bf16* HB3, float* out, const float* gain, const float* part, LAS float* red, int bx, int G, int gw, int NGW, int wave, int lane) {
    if (part) for (int hr = bx; hr < 256; hr += G) {
        const int r = M - 256 + hr, b = r / LP, p = r - b * LP;
        f32x4 v[2]; float ss = 0.f;
#pragma unroll
        for (int j = 0; j < 2; ++j) { const size_t c = (size_t)(512 * wave + 256 * j + 4 * lane); v[j] = bf4_to_f32(*(const v2u*)(Hprev + (size_t)r * D + c));
#pragma unroll
            for (int s = 0; s < 16; ++s) v[j] = v[j] + *(const f32x4*)(part + ((size_t)s * 256 + hr) * D + c);
            ss += (v[j].x * v[j].x + v[j].y * v[j].y) + (v[j].z * v[j].z + v[j].w * v[j].w); }
        ss = wave_sum(ss);
        if (lane == 0) red[wave] = ss;
        __syncthreads();
        float tot = 0.f;
#pragma unroll
        for (int w = 0; w < NWAVES; ++w) tot += red[w];
        __syncthreads();
        const float rs = 1.0f / sqrtf(tot * (1.0f / D) + EPS);
#pragma unroll
        for (int j = 0; j < 2; ++j) { const size_t c = (size_t)(512 * wave + 256 * j + 4 * lane); const f32x4 g = *(const f32x4*)(gain + c);
            *(f32x4*)(out + ((size_t)b * SEQ + (size_t)(p - 128)) * D + c) = v[j] * rs * g; }
    }
    for (int r = gw; r < (part ? M - 256 : M); r += NGW) {
        const int b = r / LP, p = r - b * LP;
        if (p < 128) continue;
        float ss = 0.f; v4u wq[8];
#pragma unroll
        for (int j = 0; j < 8; ++j) { const v4u w = ((const v4u*)(HB3 + (size_t)r * D))[lane + 64 * j]; wq[j] = w;
            const float a0 = bf2f(w.x & 0xffffu), a1 = bf2f(w.x >> 16), a2 = bf2f(w.y & 0xffffu), a3 = bf2f(w.y >> 16), a4 = bf2f(w.z & 0xffffu), a5 = bf2f(w.z >> 16), a6 = bf2f(w.w & 0xffffu), a7 = bf2f(w.w >> 16);
            ss += ((a0 * a0 + a1 * a1) + (a2 * a2 + a3 * a3)) + ((a4 * a4 + a5 * a5) + (a6 * a6 + a7 * a7)); }
        ss = wave_sum(ss);
        const float rs = 1.0f / sqrtf(ss * (1.0f / D) + EPS);
        float* orow = out + ((size_t)b * SEQ + (size_t)(p - 128)) * D;
#pragma unroll
        for (int j = 0; j < 8; ++j) { const v4u w = wq[j]; const int e0 = 8 * (lane + 64 * j);
            const f32x4 g0 = *(const f32x4*)(gain + e0), g1 = *(const f32x4*)(gain + e0 + 4);
            *(f32x4*)(orow + e0) = (f32x4){bf2f(w.x & 0xffffu), bf2f(w.x >> 16), bf2f(w.y & 0xffffu), bf2f(w.y >> 16)} * rs * g0;
            *(f32x4*)(orow + e0 + 4) = (f32x4){bf2f(w.z & 0xffffu), bf2f(w.z >> 16), bf2f(w.w & 0xffffu), bf2f(w.w >> 16)} * rs * g1; }
    }
}
constexpr int NSL = 16;
template <int MODE>
__device__ __forceinline__ void rows_phase(const float* x, const float* meta, float* H, bf16* XN, float* out, const float* gain, int gw, int NGW, int lane,
                                           const float* part = nullptr, LAS float* red = nullptr, int bx = 0, int G = 1, int wave = 0) {
    if (MODE != 0 && part) {
        for (int hr = bx; hr < 256; hr += G) {
            const int r = M - 256 + hr, b = r / LP, p = r - b * LP;
            f32x4 v[2]; float ss = 0.f;
#pragma unroll
            for (int j = 0; j < 2; ++j) { const size_t c = (size_t)(512 * wave + 256 * j + 4 * lane); v[j] = *(const f32x4*)(H + (size_t)r * D + c);
#pragma unroll
                for (int s = 0; s < NSL; ++s) v[j] = v[j] + *(const f32x4*)(part + ((size_t)s * 256 + hr) * D + c);
                if (MODE == 1) *(f32x4*)(H + (size_t)r * D + c) = v[j];
                ss += (v[j].x * v[j].x + v[j].y * v[j].y) + (v[j].z * v[j].z + v[j].w * v[j].w); }
            ss = wave_sum(ss);
            if (lane == 0) red[wave] = ss;
            __syncthreads();
            float tot = 0.f;
#pragma unroll
            for (int w = 0; w < NWAVES; ++w) tot += red[w];
            __syncthreads();
            const float rstd = 1.0f / sqrtf(tot * (1.0f / D) + EPS);
#pragma unroll
            for (int j = 0; j < 2; ++j) { const size_t c = (size_t)(512 * wave + 256 * j + 4 * lane); const f32x4 g = *(const f32x4*)(gain + c); const f32x4 y = v[j] * rstd * g;
                if (MODE == 1) { v2u w; w.x = pk2(y.x, y.y); w.y = pk2(y.z, y.w); *(v2u*)(XN + (size_t)r * D + c) = w; }
                else *(f32x4*)(out + ((size_t)b * SEQ + (size_t)(p - 128)) * D + c) = y; }
        }
    }
    const int MEND = (MODE != 0 && part) ? M - 256 : M;
    for (int r = gw; r < MEND; r += NGW) {
        const int b = r / LP, p = r - b * LP;
        if (MODE == 2 && p < 128) continue;
        const float* src; bool zero = false;
        if (MODE == 0) { if (p < NPAD) { zero = true; src = x; } else if (p < 128) src = meta + (size_t)(p - NPAD) * D; else src = x + ((size_t)b * SEQ + (size_t)(p - 128)) * D; }
        else src = H + (size_t)r * D;
        f32x4 v[16]; float ss = 0.f;
#pragma unroll
        for (int j = 0; j < 16; ++j) { v[j] = zero ? (f32x4){0.f, 0.f, 0.f, 0.f} : ((const f32x4*)src)[lane + 64 * j]; ss += (v[j].x * v[j].x + v[j].y * v[j].y) + (v[j].z * v[j].z + v[j].w * v[j].w); }
        ss = wave_sum(ss);
        const float rstd = 1.0f / sqrtf(ss * (1.0f / D) + EPS);
#pragma unroll
        for (int j = 0; j < 16; ++j) { const f32x4 g = ((const f32x4*)gain)[lane + 64 * j]; const f32x4 y = v[j] * rstd * g;
            if (MODE == 0) ((f32x4*)(H + (size_t)r * D))[lane + 64 * j] = v[j];
            if (MODE != 2) { v2u w; w.x = pk2(y.x, y.y); w.y = pk2(y.z, y.w); ((v2u*)(XN + (size_t)r * D))[lane + 64 * j] = w; }
            else ((f32x4*)(out + ((size_t)b * SEQ + (size_t)(p - 128)) * D))[lane + 64 * j] = y; }
    }
}
template <bool GU, bool HAS_GAIN = false>
__device__ __forceinline__ void transpose_item(const float* W, int K, int N, bf16* WT, LAS float* scr, int item, int lane, const float* gain = nullptr) {
    const int nblk = N / 32, kb = item / nblk, nb = item - kb * nblk, k0 = 64 * kb, n0 = 32 * nb;
    int drow0 = n0;
    if (GU) { const int hh = (n0 >= FF) ? 1 : 0, nn = n0 - hh * FF; drow0 = 256 * (nn >> 7) + 128 * hh + (nn & 127); }
    float wv[32];
#pragma unroll
    for (int i = 0; i < 32; ++i) wv[i] = W[(size_t)(k0 + 2 * i + (lane >> 5)) * N + n0 + (lane & 31)];
    if (HAS_GAIN) {
        float gv[32];
#pragma unroll
        for (int i = 0; i < 32; ++i) gv[i] = gain[k0 + 2 * i + (lane >> 5)];
#pragma unroll
        for (int i = 0; i < 32; ++i) wv[i] *= gv[i];
    }
#pragma unroll
    for (int i = 0; i < 32; ++i) scr[(2 * i + (lane >> 5)) * 33 + (lane & 31)] = wv[i];
    LDS_WAIT(); asm volatile("" ::: "memory");
    const int c = lane & 7;
#pragma unroll
    for (int j = 0; j < 4; ++j) { const int n = (lane >> 3) + 8 * j; const LAS float* s = scr + (8 * c) * 33 + n;
        v4u o; o.x = pk2(s[0 * 33], s[1 * 33]); o.y = pk2(s[2 * 33], s[3 * 33]); o.z = pk2(s[4 * 33], s[5 * 33]); o.w = pk2(s[6 * 33], s[7 * 33]);
        *(v4u*)(WT + (size_t)(drow0 + n) * K + k0 + 8 * c) = o; }
    LDS_WAIT(); asm volatile("" ::: "memory");
}

__device__ __forceinline__ void fwht32(float (&v)[32]) {
#pragma unroll
    for (int len = 1; len < 32; len <<= 1)
#pragma unroll
        for (int i = 0; i < 32; ++i) if (!(i & len)) { const float a = v[i], b = v[i + len]; v[i] = a + b; v[i + len] = a - b; }
#pragma unroll
    for (int i = 0; i < 32; ++i) v[i] *= 0.17677669529663687f;
}
__device__ __forceinline__ void transpose_item_rot(const float* W, int K, int N, bf16* WT, LAS float* scr, int item, int lane, unsigned* colmax_bits) {
    const int nblk = N / 32, kb = item / nblk, nb = item - kb * nblk, k0 = 64 * kb, n0 = 32 * nb;
    float wv[32];
#pragma unroll
    for (int i = 0; i < 32; ++i) wv[i] = W[(size_t)(k0 + 2 * i + (lane >> 5)) * N + n0 + (lane & 31)];
#pragma unroll
    for (int i = 0; i < 32; ++i) scr[(2 * i + (lane >> 5)) * 33 + (lane & 31)] = wv[i];
    LDS_WAIT(); asm volatile("" ::: "memory");
    { float v[32]; const int n = lane & 31, hb = 32 * (lane >> 5);
#pragma unroll
        for (int i = 0; i < 32; ++i) v[i] = scr[(hb + i) * 33 + n];
        fwht32(v);
        float m = 0.f;
#pragma unroll
        for (int i = 0; i < 32; ++i) { scr[(hb + i) * 33 + n] = v[i]; m = fmaxf(m, fabsf(v[i])); }
        if (colmax_bits) { m = fmaxf(m, __shfl_xor(m, 32)); if (lane < 32) atomicMax(colmax_bits + n0 + n, __float_as_uint(m)); } }
    LDS_WAIT(); asm volatile("" ::: "memory");
    const int c = lane & 7;
#pragma unroll
    for (int j = 0; j < 4; ++j) { const int n = (lane >> 3) + 8 * j; const LAS float* s = scr + (8 * c) * 33 + n;
        v4u o; o.x = pk2(s[0 * 33], s[1 * 33]); o.y = pk2(s[2 * 33], s[3 * 33]); o.z = pk2(s[4 * 33], s[5 * 33]); o.w = pk2(s[6 * 33], s[7 * 33]);
        *(v4u*)(WT + (size_t)(n0 + n) * K + k0 + 8 * c) = o; }
    LDS_WAIT(); asm volatile("" ::: "memory");
}
__device__ __forceinline__ unsigned q8pack(float a, float b, float c, float d, float inv) {
    const int b0 = (int)fminf(fmaxf(rintf(a * inv), -127.f), 127.f), b1 = (int)fminf(fmaxf(rintf(b * inv), -127.f), 127.f), b2 = (int)fminf(fmaxf(rintf(c * inv), -127.f), 127.f), b3 = (int)fminf(fmaxf(rintf(d * inv), -127.f), 127.f);
    return (unsigned)(b0 & 0xff) | ((unsigned)(b1 & 0xff) << 8) | ((unsigned)(b2 & 0xff) << 16) | ((unsigned)(b3 & 0xff) << 24);
}
__device__ __forceinline__ void rows_to_int8(const bf16* src, unsigned char* dst, const unsigned* maxbits, int nrows, int width, int gw, int NGW, int lane) {
    const int chunks = width / 8;
    for (int r = gw; r < nrows; r += NGW) {
        const float am = __uint_as_float(maxbits[r]), inv = am > 0.f ? 127.0f / am : 0.f;
        const v4u* s = (const v4u*)(src + (size_t)r * width); v2u* d = (v2u*)(dst + (size_t)r * width);
        for (int ci = lane; ci < chunks; ci += 64) { const v4u w = s[ci];
            v2u o; o.x = q8pack(bf2f(w.x & 0xffffu), bf2f(w.x >> 16), bf2f(w.y & 0xffffu), bf2f(w.y >> 16), inv); o.y = q8pack(bf2f(w.z & 0xffffu), bf2f(w.z >> 16), bf2f(w.w & 0xffffu), bf2f(w.w >> 16), inv);
            d[ci] = o; }
    }
}
constexpr int RQ_LANES = 4; constexpr float RQ_SCALE = 0.17677669529663687f;
__device__ __forceinline__ unsigned q8pack_fast(float a, float b, float c, float d, float s) {
    const unsigned t0 = __float_as_uint(fmaf(a, s, 12582912.0f)), t1 = __float_as_uint(fmaf(b, s, 12582912.0f)), t2 = __float_as_uint(fmaf(c, s, 12582912.0f)), t3 = __float_as_uint(fmaf(d, s, 12582912.0f));
    return __builtin_amdgcn_perm(__builtin_amdgcn_perm(t3, t2, 0x0c0c0400u), __builtin_amdgcn_perm(t1, t0, 0x0c0c0400u), 0x05040100u);
}
template <bool TOK>
__device__ __forceinline__ void act_rot_quant(const bf16* src, unsigned char* dst, unsigned* rowmax, int gw, int NGW, int lane) {
    constexpr int CH = FF / 8, NJ = (CH + 63) / 64;
    constexpr float RS = RQ_SCALE;
    for (int r = gw; r < M; r += NGW) {
        if (TOK && (r % LP) < 128) continue;
        const v4u* s = (const v4u*)(src + (size_t)r * FF); v2u* d = (v2u*)(dst + (size_t)r * FF);
        float v[NJ][8]; float am = 0.f;
#pragma unroll
        for (int j = 0; j < NJ; ++j) { const int ci = lane + 64 * j; v4u w = (v4u){0u, 0u, 0u, 0u}; if (ci < CH) w = s[ci];
            v[j][0] = __uint_as_float(w.x << 16); v[j][1] = __uint_as_float(w.x & 0xffff0000u); v[j][2] = __uint_as_float(w.y << 16); v[j][3] = __uint_as_float(w.y & 0xffff0000u);
            v[j][4] = __uint_as_float(w.z << 16); v[j][5] = __uint_as_float(w.z & 0xffff0000u); v[j][6] = __uint_as_float(w.w << 16); v[j][7] = __uint_as_float(w.w & 0xffff0000u); }
#pragma unroll
        for (int j = 0; j < NJ; ++j) {
#pragma unroll
            for (int len = 1; len < 8; len <<= 1)
#pragma unroll
                for (int i = 0; i < 8; ++i) if (!(i & len)) { const float x0 = v[j][i], x1 = v[j][i + len]; v[j][i] = x0 + x1; v[j][i + len] = x0 - x1; }
#pragma unroll
            for (int bit = 1; bit < RQ_LANES; bit <<= 1) { const float sg = (lane & bit) ? -1.0f : 1.0f;
#pragma unroll
                for (int i = 0; i < 8; ++i) v[j][i] = fmaf(v[j][i], sg, __shfl_xor(v[j][i], bit)); }
#pragma unroll
            for (int i = 0; i < 8; ++i) am = fmaxf(am, fabsf(v[j][i])); }
#pragma unroll
        for (int o = 1; o < 64; o <<= 1) am = fmaxf(am, __shfl_xor(am, o));
        const float qs = am > 0.f ? 127.0f / am : 0.f;
        if (lane == 0) rowmax[r] = __float_as_uint(am * RS);
#pragma unroll
        for (int j = 0; j < NJ; ++j) { const int ci = lane + 64 * j; v2u o; o.x = q8pack_fast(v[j][0], v[j][1], v[j][2], v[j][3], qs); o.y = q8pack_fast(v[j][4], v[j][5], v[j][6], v[j][7], qs); if (ci < CH) d[ci] = o; }
    }
}
__device__ __forceinline__ void colmax_item(const float* W, int K, int N, const float* gain, unsigned* colmax_bits, int item, int lane) {
    const int nblk = N / 32, kb = item / nblk, nb = item - kb * nblk, k0 = 64 * kb, n0 = 32 * nb;
    const int hh = (n0 >= FF) ? 1 : 0, nn = n0 - hh * FF, drow0 = 256 * (nn >> 7) + 128 * hh + (nn & 127);
    float wv[32], gv[32];
#pragma unroll
    for (int i = 0; i < 32; ++i) wv[i] = W[(size_t)(k0 + 2 * i + (lane >> 5)) * N + n0 + (lane & 31)];
#pragma unroll
    for (int i = 0; i < 32; ++i) gv[i] = gain[k0 + 2 * i + (lane >> 5)];
    float m = 0.f;
#pragma unroll
    for (int i = 0; i < 32; ++i) m = fmaxf(m, fabsf(wv[i] * gv[i]));
    m = fmaxf(m, __shfl_xor(m, 32));
    if (lane < 32) atomicMax(colmax_bits + drow0 + lane, __float_as_uint(m));
}
__device__ __forceinline__ void quant_item(const float* W, int K, int N, unsigned char* WT, LAS float* scr, int item, int lane, const float* gain, const float* colmax) {
    const int nblk = N / 32, kb = item / nblk, nb = item - kb * nblk, k0 = 64 * kb, n0 = 32 * nb;
    const int hh = (n0 >= FF) ? 1 : 0, nn = n0 - hh * FF, drow0 = 256 * (nn >> 7) + 128 * hh + (nn & 127);
    float wv[32], gv[32];
#pragma unroll
    for (int i = 0; i < 32; ++i) wv[i] = W[(size_t)(k0 + 2 * i + (lane >> 5)) * N + n0 + (lane & 31)];
#pragma unroll
    for (int i = 0; i < 32; ++i) gv[i] = gain[k0 + 2 * i + (lane >> 5)];
    const float cm = colmax[drow0 + (lane & 31)], inv = cm > 0.f ? 127.0f / cm : 0.f;
#pragma unroll
    for (int i = 0; i < 32; ++i) scr[(2 * i + (lane >> 5)) * 33 + (lane & 31)] = rintf((wv[i] * gv[i]) * inv);
    LDS_WAIT(); asm volatile("" ::: "memory");
    const int c = lane & 3;
#pragma unroll
    for (int ps = 0; ps < 2; ++ps) { const int n = (lane >> 2) + 16 * ps; const LAS float* s = scr + (16 * c) * 33 + n; unsigned wd[4];
#pragma unroll
        for (int w4 = 0; w4 < 4; ++w4) { const int b0 = (int)s[(4 * w4 + 0) * 33], b1 = (int)s[(4 * w4 + 1) * 33], b2 = (int)s[(4 * w4 + 2) * 33], b3 = (int)s[(4 * w4 + 3) * 33];
            wd[w4] = (unsigned)(b0 & 0xff) | ((unsigned)(b1 & 0xff) << 8) | ((unsigned)(b2 & 0xff) << 16) | ((unsigned)(b3 & 0xff) << 24); }
        *(v4u*)(WT + (size_t)(drow0 + n) * K + k0 + 16 * c) = (v4u){wd[0], wd[1], wd[2], wd[3]}; }
    LDS_WAIT(); asm volatile("" ::: "memory");
}
__device__ __forceinline__ void rows_init8(const float* x, const float* meta, unsigned char* XN8, float* rowfac, int gw, int NGW, int lane) {
    for (int r = gw; r < M; r += NGW) {
        const int b = r / LP, p = r - b * LP;
        const bool zero = p < NPAD; const float* src = (p < 128) ? meta + (size_t)(zero ? 0 : p - NPAD) * D : x + ((size_t)b * SEQ + (size_t)(p - 128)) * D;
        f32x4 v[16]; float ss = 0.f, am = 0.f;
#pragma unroll
        for (int j = 0; j < 16; ++j) { v[j] = zero ? (f32x4){0.f, 0.f, 0.f, 0.f} : ((const f32x4*)src)[lane + 64 * j]; ss += (v[j].x * v[j].x + v[j].y * v[j].y) + (v[j].z * v[j].z + v[j].w * v[j].w);
            am = fmaxf(fmaxf(am, fmaxf(fabsf(v[j].x), fabsf(v[j].y))), fmaxf(fabsf(v[j].z), fabsf(v[j].w))); }
        ss = wave_sum(ss);
#pragma unroll
        for (int o = 1; o < 64; o <<= 1) am = fmaxf(am, __shfl_xor(am, o));
        const float rs = 1.0f / sqrtf(ss * (1.0f / D) + EPS), amn = am * rs, inv = amn > 0.f ? 127.0f / amn : 0.f, sc = rs * inv;
        if (lane == 0) rowfac[r] = amn * (1.0f / 127.0f);
#pragma unroll
        for (int j = 0; j < 16; ++j) { const int b0 = (int)rintf(v[j].x * sc), b1 = (int)rintf(v[j].y * sc), b2 = (int)rintf(v[j].z * sc), b3 = (int)rintf(v[j].w * sc);
            ((unsigned*)(XN8 + (size_t)r * D))[lane + 64 * j] = (unsigned)(b0 & 0xff) | ((unsigned)(b1 & 0xff) << 8) | ((unsigned)(b2 & 0xff) << 16) | ((unsigned)(b3 & 0xff) << 24); }
    }
}

__device__ __forceinline__ void attn_unit(LAS unsigned char* lds, const bf16* PROJ, bf16* MG, const float* sinks, int b, int n, int g, int tid, int wave, int lane) {
    asm volatile("" : "+v"(tid), "+v"(lane));
    constexpr int RS = 160;
    LAS unsigned char* Kl = lds; LAS unsigned char* Vl = lds + 256 * RS;
    const long row_first = (long)b * LP + (long)(n - 1) * 128;
    { v4u kr[4], vr[4];
#pragma unroll
    for (int it = 0; it < 4; ++it) { const int c = tid + 512 * it, j = c >> 3, ch = c & 7;
        kr[it] = (v4u){0u, 0u, 0u, 0u}; vr[it] = (v4u){0u, 0u, 0u, 0u};
        if (n > 0 || j >= 128) { const bf16* rp = PROJ + (size_t)(row_first + j) * INW + 64 * g + 8 * ch; kr[it] = *(const v4u*)(rp + OFF_KA); vr[it] = *(const v4u*)(rp + OFF_VA); } }
#pragma unroll
    for (int it = 0; it < 4; ++it) { const int c = tid + 512 * it, j = c >> 3, ch = c & 7;
        *(LAS v4u*)(Kl + j * RS + 16 * ch) = kr[it]; *(LAS v4u*)(Vl + j * RS + 16 * ch) = vr[it]; } }
    __syncthreads();
    const int hq = 8 * g + wave, fr = lane & 15, q = lane >> 4, ta = fr >> 2, tp = lane & 3;
    const float slope2 = exp2f(-0.25f * (float)(hq + 1)) * LOG2E;
    const float sink2 = sinks[hq] * LOG2E;
    const float qscale = 0.125f * LOG2E;
    float bias[9][4];
#pragma unroll
    for (int t = 0; t < 9; ++t)
#pragma unroll
        for (int r = 0; r < 4; ++r) { const int dist = 128 + fr - 16 * t - 4 * q - r; bias[t][r] = (dist >= 0 && dist < 128) ? -slope2 * (float)dist : -1e30f; }
    bf16x8 qn[2];
    { const size_t qrow = (size_t)b * LP + (size_t)n * 128 + (size_t)((n == 0 ? 112 : 0) + fr);
#pragma unroll
      for (int s = 0; s < 2; ++s) qn[s] = *(const bf16x8*)(PROJ + qrow * INW + OFF_QA + hq * 64 + 32 * s + 8 * q); }
    for (int qt = 0; qt < 8; ++qt) {
        if (n == 0 && qt < 7) {
            const size_t qrow0z = (size_t)b * LP + (size_t)(16 * qt);
#pragma unroll
            for (int k = 0; k < 2; ++k) { const int c = lane + 64 * k, row = c >> 3, ch = c & 7; *(v4u*)(MG + (qrow0z + row) * D + hq * 64 + 8 * ch) = (v4u){0u, 0u, 0u, 0u}; }
            continue; }
        const int i = 16 * qt + fr; const size_t qrow = (size_t)b * LP + (size_t)n * 128 + (size_t)i;
        bf16x8 qf[2];
#pragma unroll
        for (int s = 0; s < 2; ++s) qf[s] = qn[s];
        { const size_t qrown = qrow + (qt < 7 ? 16 : 0);
#pragma unroll
          for (int s = 0; s < 2; ++s) qn[s] = *(const bf16x8*)(PROJ + qrown * INW + OFF_QA + hq * 64 + 32 * s + 8 * q); }
        f32x4 sc[9];
#pragma unroll
        for (int t = 0; t < 9; ++t) { const LAS unsigned char* kp = Kl + (16 * (qt + t) + fr) * RS + 16 * q; f32x4 a = (f32x4){0.f, 0.f, 0.f, 0.f};
#pragma unroll
            for (int s = 0; s < 2; ++s) a = MFMA16(*(const LAS bf16x8*)(kp + 64 * s), qf[s], a);
            sc[t] = a; }
        float mx = -1e30f;
#pragma unroll
        for (int t = 0; t < 9; ++t)
#pragma unroll
            for (int r = 0; r < 4; ++r) sc[t][r] = fmaf(sc[t][r], qscale, bias[t][r]);
        if (n < 2) {
            asm volatile("" ::: "memory");
#pragma unroll
            for (int t = 0; t < 9; ++t)
#pragma unroll
                for (int r = 0; r < 4; ++r) { const int kpos = (n - 1) * 128 + 16 * (qt + t) + 4 * q + r; if (kpos < NPAD) sc[t][r] = -1e30f; } }
#pragma unroll
        for (int t = 0; t < 9; ++t)
#pragma unroll
            for (int r = 0; r < 4; ++r) mx = fmaxf(mx, sc[t][r]);
        mx = fmaxf(mx, __shfl_xor(mx, 16)); mx = fmaxf(mx, __shfl_xor(mx, 32));
        const float m2 = fmaxf(mx, sink2);
        float sum = 0.f;
#pragma unroll
        for (int t = 0; t < 9; ++t)
#pragma unroll
            for (int r = 0; r < 4; ++r) { const float p = __builtin_amdgcn_exp2f(sc[t][r] - m2); sc[t][r] = p; sum += p; }
        sum += __shfl_xor(sum, 16); sum += __shfl_xor(sum, 32);
        const float inv = 1.0f / (sum + __builtin_amdgcn_exp2f(sink2 - m2));
        f32x4 o[4];
#pragma unroll
        for (int dt = 0; dt < 4; ++dt) o[dt] = (f32x4){0.f, 0.f, 0.f, 0.f};
#pragma unroll
        for (int sp = 0; sp < 5; ++sp) { const int T0 = qt + 2 * sp; int T1 = T0 + 1; if (T1 > 15) T1 = 15;
            v4u pw; pw.x = pk2(sc[2 * sp][0], sc[2 * sp][1]); pw.y = pk2(sc[2 * sp][2], sc[2 * sp][3]);
            if (2 * sp + 1 < 9) { pw.z = pk2(sc[(2 * sp + 1) % 9][0], sc[(2 * sp + 1) % 9][1]); pw.w = pk2(sc[(2 * sp + 1) % 9][2], sc[(2 * sp + 1) % 9][3]); } else { pw.z = 0u; pw.w = 0u; }
            const bf16x8 pb = __builtin_bit_cast(bf16x8, pw);
#pragma unroll
            for (int dt = 0; dt < 4; ++dt) { const s16x4 lo = ds_tr16(Vl + (16 * T0 + 4 * q + ta) * RS + (16 * dt + 4 * tp) * 2), hi = ds_tr16(Vl + (16 * T1 + 4 * q + ta) * RS + (16 * dt + 4 * tp) * 2);
                o[dt] = MFMA16(cat8(lo, hi), pb, o[dt]); } }
        LAS unsigned char* Ow = lds + 81920 + wave * 2304;
#pragma unroll
        for (int dt = 0; dt < 4; ++dt) { const f32x4 ov = o[dt] * inv; v2u w; w.x = pk2(ov[0], ov[1]); w.y = pk2(ov[2], ov[3]); *(LAS v2u*)(Ow + fr * 144 + (16 * dt + 4 * q) * 2) = w; }
        LDS_WAIT();
        const size_t qrow0 = (size_t)b * LP + (size_t)n * 128 + (size_t)(16 * qt);
#pragma unroll
        for (int k = 0; k < 2; ++k) { const int c = lane + 64 * k, row = c >> 3, ch = c & 7; const v4u v = *(const LAS v4u*)(Ow + row * 144 + 16 * ch); *(v4u*)(MG + (qrow0 + row) * D + hq * 64 + 8 * ch) = v; }
        LDS_WAIT();
    }
    __syncthreads();
}

__device__ __forceinline__ void kv_unit(LAS unsigned char* lds, const bf16* PROJ, bf16* ST, int b, int h, int n, int tid, int wave, int lane) {
    asm volatile("" : "+v"(tid), "+v"(lane));
    constexpr int RS = 544;
    LAS unsigned char* Kl = lds; LAS unsigned char* Vl = lds + 128 * RS;
    const float lg = log2_gamma(h);
    const size_t row0 = (size_t)b * LP + (size_t)n * 128;
    v4u kr[8], vr[8];
#pragma unroll
    for (int it = 0; it < 8; ++it) { const int c = tid + 512 * it, j = c >> 5, ch = c & 31; const bf16* rp = PROJ + (row0 + j) * INW + 256 * h + 8 * ch;
        kr[it] = *(const v4u*)(rp + OFF_KR); vr[it] = *(const v4u*)(rp + OFF_VR); }
#pragma unroll
    for (int it = 0; it < 8; ++it) { const int c = tid + 512 * it, j = c >> 5, ch = c & 31;
        v4u kv = kr[it]; const v4u vv = vr[it];
        const float w = __builtin_amdgcn_exp2f((float)(127 - j) * lg) * 0.0625f;
        kv.x = pk2(bf2f(kv.x & 0xffffu) * w, bf2f(kv.x >> 16) * w); kv.y = pk2(bf2f(kv.y & 0xffffu) * w, bf2f(kv.y >> 16) * w);
        kv.z = pk2(bf2f(kv.z & 0xffffu) * w, bf2f(kv.z >> 16) * w); kv.w = pk2(bf2f(kv.w & 0xffffu) * w, bf2f(kv.w >> 16) * w);
        *(LAS v4u*)(Kl + j * RS + 16 * ch) = kv; *(LAS v4u*)(Vl + j * RS + 16 * ch) = vv; }
    __syncthreads();
    const int fr = lane & 15, q = lane >> 4, ta = fr >> 2, tp = lane & 3;
    const int dt0 = 4 * (wave & 3), et0 = 8 * (wave >> 2);
    f32x4 acc[4][8];
#pragma unroll
    for (int a = 0; a < 4; ++a)
#pragma unroll
        for (int e = 0; e < 8; ++e) acc[a][e] = (f32x4){0.f, 0.f, 0.f, 0.f};
#pragma unroll
    for (int s = 0; s < 4; ++s) {
        bf16x8 af[4], bfr[8];
#pragma unroll
        for (int a = 0; a < 4; ++a) { const LAS unsigned char* p = Kl + (32 * s + 8 * q + ta) * RS + (16 * (dt0 + a) + 4 * tp) * 2; af[a] = cat8(ds_tr16(p), ds_tr16(p + 4 * RS)); }
#pragma unroll
        for (int e = 0; e < 8; ++e) { const LAS unsigned char* p = Vl + (32 * s + 8 * q + ta) * RS + (16 * (et0 + e) + 4 * tp) * 2; bfr[e] = cat8(ds_tr16(p), ds_tr16(p + 4 * RS)); }
#pragma unroll
        for (int a = 0; a < 4; ++a)
#pragma unroll
            for (int e = 0; e < 8; ++e) acc[a][e] = MFMA16(af[a], bfr[e], acc[a][e]);
    }
    bf16* sp = ST + ((size_t)(n * 2 + b) * 8 + h) * 65536;
    __syncthreads();
#pragma unroll
    for (int a = 0; a < 4; ++a)
#pragma unroll
        for (int e = 0; e < 8; ++e) { v2u w; w.x = pk2(acc[a][e][0], acc[a][e][1]); w.y = pk2(acc[a][e][2], acc[a][e][3]); *(LAS v2u*)(lds + (16 * (et0 + e) + fr) * 528 + (16 * (dt0 + a) + 4 * q) * 2) = w; }
    __syncthreads();
#pragma unroll
    for (int it = 0; it < 16; ++it) { const int c = tid + 512 * it, row = ((c >> 5) + 37 * (int)blockIdx.x) & 255, ch = c & 31; const v4u v = *(const LAS v4u*)(lds + row * 528 + 16 * ch); *(v4u*)(sp + (size_t)row * 256 + 8 * ch) = v; }
    __syncthreads();
}
#define BAR_LDS() asm volatile("s_waitcnt lgkmcnt(0)\n\ts_barrier" ::: "memory")
__device__ __forceinline__ void kv_phase(LAS unsigned char* lds, const bf16* PROJ, bf16* ST, int bx, int G, int tid, int wave, int lane) {
    asm volatile("" : "+v"(tid), "+v"(lane));
    constexpr int RS = 544;
    LAS unsigned char* Kl = lds; LAS unsigned char* Vl = lds + 128 * RS;
    const int dt0 = 4 * (wave & 3), et0 = 8 * (wave >> 2);
    v4u kr[8], vr[8];
#define KV_LOAD(u_) do { const int b_ = ((u_) & 15) >> 3, h_ = (u_) & 7, n_ = (u_) >> 4; const size_t r0_ = (size_t)b_ * LP + (size_t)n_ * 128; \
        _Pragma("unroll") for (int it = 0; it < 8; ++it) { const int c = tid + 512 * it, j = c >> 5, ch = c & 31; const bf16* rp = PROJ + (r0_ + j) * INW + 256 * h_ + 8 * ch; \
            kr[it] = *(const v4u*)(rp + OFF_KR); vr[it] = *(const v4u*)(rp + OFF_VR); } } while (0)
    int u = bx;
    if (u < 1024) KV_LOAD(u);
    for (; u < 1024; u += G) {
        asm volatile("" : "+v"(tid), "+v"(lane));
        const int fr = lane & 15, q = lane >> 4, ta = fr >> 2, tp = lane & 3;
        const int b = (u & 15) >> 3, h = u & 7, n = u >> 4;
        const float lg = log2_gamma(h);
#pragma unroll
        for (int it = 0; it < 8; ++it) { const int c = tid + 512 * it, j = c >> 5, ch = c & 31;
            v4u kv = kr[it]; const v4u vv = vr[it];
            const float w = __builtin_amdgcn_exp2f((float)(127 - j) * lg) * 0.0625f;
            kv.x = pk2(bf2f(kv.x & 0xffffu) * w, bf2f(kv.x >> 16) * w); kv.y = pk2(bf2f(kv.y & 0xffffu) * w, bf2f(kv.y >> 16) * w);
            kv.z = pk2(bf2f(kv.z & 0xffffu) * w, bf2f(kv.z >> 16) * w); kv.w = pk2(bf2f(kv.w & 0xffffu) * w, bf2f(kv.w >> 16) * w);
            *(LAS v4u*)(Kl + j * RS + 16 * ch) = kv; *(LAS v4u*)(Vl + j * RS + 16 * ch) = vv; }
        BAR_LDS();
        f32x4 acc[4][8];
#pragma unroll
        for (int a = 0; a < 4; ++a)
#pragma unroll
            for (int e = 0; e < 8; ++e) acc[a][e] = (f32x4){0.f, 0.f, 0.f, 0.f};
#pragma unroll
        for (int s = 0; s < 4; ++s) {
            bf16x8 af[4], bfr[8];
#pragma unroll
            for (int a = 0; a < 4; ++a) { const LAS unsigned char* p = Kl + (32 * s + 8 * q + ta) * RS + (16 * (dt0 + a) + 4 * tp) * 2; af[a] = cat8(ds_tr16(p), ds_tr16(p + 4 * RS)); }
#pragma unroll
            for (int e = 0; e < 8; ++e) { const LAS unsigned char* p = Vl + (32 * s + 8 * q + ta) * RS + (16 * (et0 + e) + 4 * tp) * 2; bfr[e] = cat8(ds_tr16(p), ds_tr16(p + 4 * RS)); }
#pragma unroll
            for (int a = 0; a < 4; ++a)
#pragma unroll
                for (int e = 0; e < 8; ++e) acc[a][e] = MFMA16(af[a], bfr[e], acc[a][e]);
        }
        v2u pk[4][8];
#pragma unroll
        for (int a = 0; a < 4; ++a)
#pragma unroll
            for (int e = 0; e < 8; ++e) { pk[a][e].x = pk2(acc[a][e][0], acc[a][e][1]); pk[a][e].y = pk2(acc[a][e][2], acc[a][e][3]); }
        __builtin_amdgcn_sched_barrier(0);
        { const int un = (u + G < 1024) ? u + G : u; KV_LOAD(un); }
        __builtin_amdgcn_sched_barrier(0);
        bf16* sp = ST + ((size_t)(n * 2 + b) * 8 + h) * 65536;
        BAR_LDS();
#pragma unroll
        for (int a = 0; a < 4; ++a)
#pragma unroll
            for (int e = 0; e < 8; ++e) *(LAS v2u*)(lds + (16 * (et0 + e) + fr) * 528 + (16 * (dt0 + a) + 4 * q) * 2) = pk[a][e];
        BAR_LDS();
#pragma unroll
        for (int it = 0; it < 16; ++it) { const int c = tid + 512 * it, row = ((c >> 5) + 37 * bx) & 255, ch = c & 31; const v4u v = *(const LAS v4u*)(lds + row * 528 + 16 * ch); *(v4u*)(sp + (size_t)row * 256 + 8 * ch) = v; }
        BAR_LDS();
    }
#undef KV_LOAD
}
__device__ __forceinline__ void scan_phase(bf16* ST, int gtid, int nthreads) {
    for (int idx = gtid; idx < 16 * 8192; idx += nthreads) {
        const int bh = idx >> 13, v = idx & 8191, h = bh & 7;
        const float cd = exp2f(128.0f * log2_gamma(h));
        bf16* p = ST + (size_t)bh * 65536 + (size_t)v * 8; constexpr size_t NS = (size_t)16 * 65536;
        float s[8];
#pragma unroll
        for (int k = 0; k < 8; ++k) s[k] = 0.f;
        for (int nb = 0; nb < NCH; nb += 13) {
            v4u in[13];
#pragma unroll
            for (int k = 0; k < 13; ++k) in[k] = (nb + k < NCH - 1) ? *(const v4u*)(p + (size_t)(nb + k) * NS) : (v4u){0u, 0u, 0u, 0u};
#pragma unroll
            for (int k = 0; k < 13; ++k) { v4u o; o.x = pk2(s[0], s[1]); o.y = pk2(s[2], s[3]); o.z = pk2(s[4], s[5]); o.w = pk2(s[6], s[7]); *(v4u*)(p + (size_t)(nb + k) * NS) = o;
                s[0] = s[0] * cd + bf2f(in[k].x & 0xffffu); s[1] = s[1] * cd + bf2f(in[k].x >> 16); s[2] = s[2] * cd + bf2f(in[k].y & 0xffffu); s[3] = s[3] * cd + bf2f(in[k].y >> 16);
                s[4] = s[4] * cd + bf2f(in[k].z & 0xffffu); s[5] = s[5] * cd + bf2f(in[k].z >> 16); s[6] = s[6] * cd + bf2f(in[k].w & 0xffffu); s[7] = s[7] * cd + bf2f(in[k].w >> 16); }
        }
    }
}
__device__ __forceinline__ void ret_unit(LAS unsigned char* lds, const bf16* PROJ, const bf16* ST, bf16* MG, int b, int h, int n, int tid, int wave, int lane) {
    asm volatile("" : "+v"(tid), "+v"(lane));
    constexpr int RS = 544, SRS = 528, SBUF = 64 * SRS;
    LAS unsigned char* Kl = lds; LAS unsigned char* Vl = lds + 128 * RS;
    const float lg = log2_gamma(h);
    const size_t row0 = (size_t)b * LP + (size_t)n * 128;
    const bf16* sp = ST + ((size_t)(n * 2 + b) * 8 + h) * 65536;
    v4u sr[4];
#define RET_LOADST(c) do { _Pragma("unroll") for (int i_ = 0; i_ < 4; ++i_) { const int pc_ = tid + 512 * i_; sr[i_] = *(const v4u*)(sp + (size_t)(64 * (c) + (pc_ >> 5)) * 256 + 8 * (pc_ & 31)); } } while (0)
#define RET_WRITEST(buf) do { _Pragma("unroll") for (int i_ = 0; i_ < 4; ++i_) { const int pc_ = tid + 512 * i_; *(LAS v4u*)(Kl + (buf) * SBUF + (pc_ >> 5) * SRS + 16 * (pc_ & 31)) = sr[i_]; } } while (0)
    RET_LOADST(0);
    { v4u kr[8], vr[8];
#pragma unroll
    for (int it = 0; it < 8; ++it) { const int c = tid + 512 * it, j = c >> 5, ch = c & 31; const bf16* rp = PROJ + (row0 + j) * INW + 256 * h + 8 * ch;
        kr[it] = *(const v4u*)(rp + OFF_KR); vr[it] = *(const v4u*)(rp + OFF_VR); }
#pragma unroll
    for (int it = 0; it < 8; ++it) { const int c = tid + 512 * it, j = c >> 5, ch = c & 31;
        *(LAS v4u*)(Kl + j * RS + 16 * ch) = kr[it]; *(LAS v4u*)(Vl + j * RS + 16 * ch) = vr[it]; } }
    __syncthreads();
    const int fr = lane & 15, q = lane >> 4, ta = fr >> 2, tp = lane & 3;
    const int i = 16 * wave + fr; const size_t qrow = row0 + (size_t)i;
    bf16x8 qf[8];
#pragma unroll
    for (int s = 0; s < 8; ++s) qf[s] = *(const bf16x8*)(PROJ + qrow * INW + OFF_QR + 256 * h + 32 * s + 8 * q);
    v2u spk[8];
    const bool live = (n > 0) || (wave == NWAVES - 1);
#pragma unroll
    for (int jt = 0; jt < 8; ++jt) { f32x4 a = (f32x4){0.f, 0.f, 0.f, 0.f};
        if (jt <= wave && live) { const LAS unsigned char* kp = Kl + (16 * jt + fr) * RS + 16 * q;
#pragma unroll
            for (int s = 0; s < 8; ++s) a = MFMA16(*(const LAS bf16x8*)(kp + 64 * s), qf[s], a);
#pragma unroll
            for (int r = 0; r < 4; ++r) { const int j = 16 * jt + 4 * q + r; a[r] = (i >= j) ? a[r] * __builtin_amdgcn_exp2f((float)(i - j) * lg) * 0.0625f : 0.f; } }
        spk[jt].x = pk2(a[0], a[1]); spk[jt].y = pk2(a[2], a[3]); }
    __syncthreads();
    RET_WRITEST(0); RET_LOADST(1);
    __syncthreads();
    f32x4 acc[16];
#pragma unroll
    for (int et = 0; et < 16; ++et) acc[et] = (f32x4){0.f, 0.f, 0.f, 0.f};
#pragma unroll
    for (int c = 0; c < 4; ++c) {
        const LAS unsigned char* sb = Kl + (c & 1) * SBUF + fr * SRS + 16 * q;
        if (live) {
#pragma unroll
        for (int e4 = 0; e4 < 4; ++e4)
#pragma unroll
            for (int s = 0; s < 8; ++s) acc[4 * c + e4] = MFMA16(*(const LAS bf16x8*)(sb + 16 * e4 * SRS + 64 * s), qf[s], acc[4 * c + e4]);
        }
        if (c < 3) { RET_WRITEST((c + 1) & 1); if (c < 2) RET_LOADST(c + 2); __syncthreads(); }
    }
#undef RET_LOADST
#undef RET_WRITEST
    const float cw = __builtin_amdgcn_exp2f((float)(i + 1) * lg);
#pragma unroll
    for (int et = 0; et < 16; ++et) acc[et] = acc[et] * cw;
#pragma unroll
    for (int s2 = 0; s2 < 4; ++s2)
        if (2 * s2 <= wave && live) { v4u pw; pw.x = spk[2 * s2].x; pw.y = spk[2 * s2].y; pw.z = spk[2 * s2 + 1].x; pw.w = spk[2 * s2 + 1].y; const bf16x8 pb = __builtin_bit_cast(bf16x8, pw);
#pragma unroll
            for (int et = 0; et < 16; ++et) { const LAS unsigned char* p = Vl + (32 * s2 + 4 * q + ta) * RS + (16 * et + 4 * tp) * 2; acc[et] = MFMA16(cat8(ds_tr16(p), ds_tr16(p + 16 * RS)), pb, acc[et]); } }
    float ss = 0.f;
#pragma unroll
    for (int et = 0; et < 16; ++et) ss += (acc[et][0] * acc[et][0] + acc[et][1] * acc[et][1]) + (acc[et][2] * acc[et][2] + acc[et][3] * acc[et][3]);
    ss += __shfl_xor(ss, 16); ss += __shfl_xor(ss, 32);
    const float rstd = 1.0f / sqrtf(ss * (1.0f / 256.0f) + EPS);
    __syncthreads();
    LAS unsigned char* Rw = lds + wave * 16640;
#pragma unroll
    for (int et = 0; et < 16; ++et) *(LAS f32x4*)(Rw + fr * 1040 + (16 * et + 4 * q) * 4) = acc[et] * rstd;
    LDS_WAIT();
#pragma unroll
    for (int k = 0; k < 8; ++k) { const int c = lane + 64 * k, row = c >> 5, ch = c & 31; const size_t grow = row0 + (size_t)(16 * wave + row);
        const f32x4 a0 = *(const LAS f32x4*)(Rw + row * 1040 + 32 * ch), a1 = *(const LAS f32x4*)(Rw + row * 1040 + 32 * ch + 16);
        const v4u gw = *(const v4u*)(PROJ + grow * INW + OFF_GR + 256 * h + 8 * ch);
        v4u w; w.x = pk2(a0[0] * pg8::silu_f(bf2f(gw.x & 0xffffu)), a0[1] * pg8::silu_f(bf2f(gw.x >> 16))); w.y = pk2(a0[2] * pg8::silu_f(bf2f(gw.y & 0xffffu)), a0[3] * pg8::silu_f(bf2f(gw.y >> 16)));
        w.z = pk2(a1[0] * pg8::silu_f(bf2f(gw.z & 0xffffu)), a1[1] * pg8::silu_f(bf2f(gw.z >> 16))); w.w = pk2(a1[2] * pg8::silu_f(bf2f(gw.w & 0xffffu)), a1[3] * pg8::silu_f(bf2f(gw.w >> 16)));
        *(v4u*)(MG + grow * D + 2048 + 256 * h + 8 * ch) = w; }
    __syncthreads();
}

template <bool GU, bool HAS_GAIN>
__device__ __forceinline__ void convert_in_tail(int nunits, int G, int bx, int wave, int lane, const float* W, int K, int N, bf16* WT, LAS float* scr, const float* gain) {
    const int rounds = (nunits + G - 1) / G, nidle = rounds * G - nunits;
    int first = G - nidle, nconv = nidle; if (nidle < 8) { first = 0; nconv = G; }
    if (bx < first) return;
    const int nitems = (K / 64) * (N / 32);
    for (int it = (bx - first) * NWAVES + wave; it < nitems; it += nconv * NWAVES) transpose_item<GU, HAS_GAIN>(W, K, N, WT, scr, it, lane, gain);
}

constexpr int N_PHASES = 13;
#ifndef PROBE_REPS
#define PROBE_REPS {1,1,1,1,1,1,1,1,1,1,1,1,1}
#endif
#ifndef PROBE_T4
#define PROBE_T4 1
#endif
constexpr int REP[N_PHASES] = PROBE_REPS;
struct Args { const float* in[14]; float* out; unsigned char* ws; int ph_lo, ph_hi; };
__global__ void __launch_bounds__(NWAVES * 64, 2) hybrid_fwd(Args args) {
    extern __shared__ __attribute__((aligned(16))) unsigned char lds_raw[];
    LAS unsigned char* lds = (LAS unsigned char*)lds_raw;
    volatile LAS unsigned* MISC = (volatile LAS unsigned*)(lds + MISC_OFF);
    const int tid = threadIdx.x, lane = tid & 63, wave = __builtin_amdgcn_readfirstlane(tid >> 6);
    const int G = gridDim.x, bx = blockIdx.x, vcu = (G % 8 == 0) ? (bx % 8) * (G / 8) + bx / 8 : bx;
    const int gw = vcu * NWAVES + wave, NGW = G * NWAVES;
    unsigned char* ws = args.ws;
    const float* x = args.in[0]; const float* meta = args.in[1]; const float* g_ffn1 = args.in[2]; const float* w_gu1 = args.in[3]; const float* w_d1 = args.in[4];
    const float* g_mix = args.in[5]; const float* w_in = args.in[6]; const float* b_in = args.in[7]; const float* sinks = args.in[8]; const float* w_out = args.in[9];
    const float* g_ffn2 = args.in[10]; const float* w_gu2 = args.in[11]; const float* w_d2 = args.in[12]; const float* g_fin = args.in[13];
    bf16* HB1 = (bf16*)(ws + WS_H); bf16* HB3 = (bf16*)(ws + WS_H + 130 * MiB);
    bf16* XN = (bf16*)(ws + WS_XN); bf16* ACT = (bf16*)(ws + WS_ACT); bf16* PROJ = ACT; bf16* MG = XN; float* SQ1 = (float*)(ws + WS_ST + 32 * MiB);
    bf16* HB2 = (bf16*)(ws + WS_HB2); float* RSTD = (float*)(ws + WS_RSTD);
    bf16* WGU = (bf16*)(ws + WS_WGU); bf16* WD = (bf16*)(ws + WS_WD); bf16* WIN = (bf16*)(ws + WS_WIN); bf16* WOUT = (bf16*)(ws + WS_WOUT); bf16* ST = (bf16*)(ws + WS_ST);
    for (int u = tid; u < (LDS_BYTES - MISC_OFF) / 4; u += NWAVES * 64) ((LAS unsigned*)(lds + MISC_OFF))[u] = 0u;
    __syncthreads();
    const int lo = args.ph_lo, hi = args.ph_hi;
    XcdBarrier bar; bar.bar = (unsigned*)(ws + WS_CTL) + CW_BAR; bar.x = 0; bar.st = MISC + 8;
    if (hi - lo > 1) bar = xcd_barrier_post((unsigned*)(ws + WS_CTL) + CW_BAR, MISC + 8);
#define IN(k) (lo <= (k) && (k) < hi)
#define SEAM(k) do { if (IN(k) && IN((k) + 1)) xcd_barrier(bar); } while (0)
    LAS float* scr = (LAS float*)(lds + wave * 16384);
    LAS float* red = (LAS float*)(lds + 135168);

    unsigned* ROWMAXD1 = (unsigned*)(ws + WS_ROWMAXD1); unsigned* ROWMAXD2 = (unsigned*)(ws + WS_ROWMAXD2); float* COLMAXD1 = (float*)(ws + WS_COLMAXD1); float* COLMAXD2 = (float*)(ws + WS_COLMAXD2);
    unsigned char* ACT8 = (unsigned char*)(ws + WS_XN); unsigned char* WD8 = (unsigned char*)(ws + WS_WD8);
    float* ROWFAC = (float*)(ws + WS_ROWFAC); float* COLMAX1 = (float*)(ws + WS_COLMAX1); float* COLMAX2 = (float*)(ws + WS_COLMAX2);
    unsigned char* XN8 = (unsigned char*)XN; unsigned char* WGU8 = (unsigned char*)WGU; unsigned char* WGU8b = WGU8 + (size_t)NGU * D;
    if (IN(0)) {
        constexpr int I_GU = (D / 64) * (NGU / 32), I_D = (FF / 64) * (D / 32), I_IN = (D / 64) * (INW / 32);
        for (int it = gw; it < 2 * I_GU + I_D + I_IN; it += NGW) { int r = it;
            if (r < I_GU) { colmax_item(w_gu1, D, NGU, g_ffn1, (unsigned*)COLMAX1, r, lane); continue; } r -= I_GU;
            if (r < I_GU) { colmax_item(w_gu2, D, NGU, g_ffn2, (unsigned*)COLMAX2, r, lane); continue; } r -= I_GU;
            if (r < I_D) { transpose_item_rot(w_d1, FF, D, WD, scr, r, lane, (unsigned*)COLMAXD1); continue; } r -= I_D;
            transpose_item<false, true>(w_in, D, INW, WIN, scr, r, lane, g_mix); }
        rows_init8(x, meta, XN8, ROWFAC, gw, NGW, lane);
        xcd_barrier(bar);
        for (int it = gw; it < I_GU; it += NGW) quant_item(w_gu1, D, NGU, WGU8, scr, it, lane, g_ffn1, COLMAX1);
        rows_to_int8(WD, WD8, (const unsigned*)COLMAXD1, D, FF, gw, NGW, lane);
    }
    SEAM(0);
    if (IN(1)) for (int rep = 0; rep < REP[1]; ++rep) { pg8::Gemm g{(const bf16*)XN8, (const bf16*)WGU8, M, NGU, D}; pg8::StaticOrder S; S.init(M, NGU, G, bx); pg8::EpiSwiGLU8 E{ACT, FF, ROWFAC, COLMAX1};
        pg8::gemm_phase<pg8::EpiSwiGLU8, pg8::StaticOrder, true, true, true>(lds, g, S, E);
        convert_in_tail<false, false>((M / 256) * (NGU / 256), G, bx, wave, lane, w_out, D, D, WOUT, scr, nullptr);
        xcd_barrier(bar);
        act_rot_quant<false>(ACT, ACT8, ROWMAXD1, gw, NGW, lane); }
    SEAM(1);
    if (IN(2)) for (int rep = 0; rep < REP[2]; ++rep) { pg8::Gemm g{(const bf16*)ACT8, (const bf16*)WD8, M, D, FF}; pg8::SplitOrder S; S.init(M, D, FF / 128, G, bx, NSL_D1); pg8::EpiResid8<true> E{HB1, D, 0.5f, (float*)ST, x, meta, nullptr, LP, NPAD, SEQ, ROWMAXD1, COLMAXD1, SQ1, M};
        pg8::gemm_phase<pg8::EpiResid8<true>, pg8::SplitOrder, true, true, true>(lds, g, S, E);
        { constexpr int I_GU = (D / 64) * (NGU / 32), I_TAIL = (int)(I_GU * P2_TAIL_FRAC); const int nbusy = (G > 4 * (D / 256) * NSL_D1) ? (D / 256) * NSL_D1 : 0;
          if (bx >= nbusy) for (int it = (bx - nbusy) * NWAVES + wave; it < I_TAIL; it += (G - nbusy) * NWAVES) quant_item(w_gu2, D, NGU, WGU8b, scr, it, lane, g_ffn2, COLMAX2); } }
    SEAM(2);
    if (IN(3)) for (int rep = 0; rep < REP[3]; ++rep) {
        stats_phase<true>(x, nullptr, HB1, RSTD, (const float*)ST, red, bx, G, gw, NGW, wave, lane, nullptr, SQ1);
        constexpr int I_GU = (D / 64) * (NGU / 32), I_D = (FF / 64) * (D / 32);
        for (int it = (int)(I_GU * P2_TAIL_FRAC) + gw; it < I_GU; it += NGW) quant_item(w_gu2, D, NGU, WGU8b, scr, it, lane, g_ffn2, COLMAX2);
    }
    SEAM(3);
    if (IN(4)) for (int rep = 0; rep < REP[4]; ++rep) { pg8::Gemm g{HB1, WIN, M, INW, D}; pg8::StaticOrder S; S.init(M, INW, G, bx); pg8::EpiProj E{PROJ, INW, b_in, LP, NPAD, RSTD};
        pg8::gemm_phase<pg8::EpiProj, pg8::StaticOrder, true, true>(lds, g, S, E);
        { const int nunits = (M / 256) * (INW / 256), rounds = (nunits + G - 1) / G, nidle = rounds * G - nunits; int first = G - nidle, nconv = nidle; if (nidle < 8) { first = 0; nconv = G; }
          if (bx >= first) for (int it = (bx - first) * NWAVES + wave; it < (FF / 64) * (D / 32); it += nconv * NWAVES) transpose_item_rot(w_d2, FF, D, WD, scr, it, lane, (unsigned*)COLMAXD2); } }
    SEAM(4);
    if (IN(5)) for (int rep = 0; rep < REP[5]; ++rep) {
#ifndef PROBE_KVREP
#define PROBE_KVREP 1
#endif
#ifndef PROBE_ATREP
#define PROBE_ATREP 1
#endif
        for (int r2 = 0; r2 < PROBE_KVREP; ++r2)
        kv_phase(lds, PROJ, ST, bx, G, tid, wave, lane);
        __syncthreads();
        for (int r2 = 0; r2 < PROBE_ATREP; ++r2)
        for (int u = bx; u < 512; u += G) {   int n, b, g; if (u < 512) { n = 1 + (u >> 3); b = (u >> 2) & 1; g = u & 3; } else { n = 0; b = (u - 512) >> 2; g = u & 3; }
            attn_unit(lds, PROJ, MG, sinks, b, n, g, tid, wave, lane); }
    }
    SEAM(5);
    if (IN(6)) scan_phase(ST, vcu * (NWAVES * 64) + tid, G * NWAVES * 64);
    SEAM(6);
    if (IN(7)) for (int rep = 0; rep < REP[7]; ++rep) {
        for (int u = bx; u < 1024; u += G) { int n, bh; if (u < 1024) { n = 1 + (u >> 4); bh = u & 15; } else { n = 0; bh = u - 1024; }
            ret_unit(lds, PROJ, ST, MG, bh >> 3, bh & 7, n, tid, wave, lane); }
    }
    SEAM(7);
    if (IN(8)) for (int rep = 0; rep < REP[8]; ++rep) { pg8::Gemm g{MG, WOUT, M, D, D}; pg8::StaticOrder S; S.init(NB * SEQ, D, G, bx, 128, 32); pg8::EpiResid<false> E{HB2, D, 1.0f, nullptr, nullptr, nullptr, HB1, LP, NPAD, SEQ};
        pg8::gemm_phase<pg8::EpiResid<false>, pg8::StaticOrder, true, true>(lds, g, S, E); }
    SEAM(8);
    if (IN(9)) for (int rep = 0; rep < REP[9]; ++rep) { stats_phase<false, true>(nullptr, HB1, HB2, ROWFAC, nullptr, red, bx, G, gw, NGW, wave, lane, XN8); }
    SEAM(9);
    if (IN(10)) for (int rep = 0; rep < REP[10]; ++rep) { pg8::Gemm g{(const bf16*)XN8, (const bf16*)WGU8b, M, NGU, D}; pg8::StaticOrder S; S.init(NB * SEQ, NGU, G, bx, 128, 32); pg8::EpiSwiGLU8 E{ACT, FF, ROWFAC, COLMAX2};
        pg8::gemm_phase<pg8::EpiSwiGLU8, pg8::StaticOrder, true, true, true>(lds, g, S, E);
        { const int nunits = (NB * SEQ / 256) * (NGU / 256), rounds = (nunits + G - 1) / G, nidle = rounds * G - nunits;
          if (nidle >= 8) { if (bx >= G - nidle) rows_to_int8(WD, WD8, (const unsigned*)COLMAXD2, D, FF, (bx - (G - nidle)) * NWAVES + wave, nidle * NWAVES, lane); }
          else rows_to_int8(WD, WD8, (const unsigned*)COLMAXD2, D, FF, gw, NGW, lane); }
        xcd_barrier(bar);
        act_rot_quant<true>(ACT, ACT8, ROWMAXD2, gw, NGW, lane); }
    SEAM(10);
    if (IN(11)) for (int rep = 0; rep < REP[11]; ++rep) { pg8::Gemm g{(const bf16*)ACT8, (const bf16*)WD8, M, D, FF}; pg8::StaticOrder S; S.init(NB * SEQ, D, G, bx, 128, 32); pg8::EpiResid8<false> E{HB3, D, 0.5f, nullptr, nullptr, nullptr, HB2, LP, NPAD, SEQ, ROWMAXD2, COLMAXD2, nullptr, 0};
        pg8::gemm_phase<pg8::EpiResid8<false>, pg8::StaticOrder, true, true, true>(lds, g, S, E); }
    SEAM(11);
    if (IN(12)) for (int rep = 0; rep < REP[12]; ++rep) final_phase(HB2, HB3, args.out, g_fin, nullptr, red, bx, G, gw, NGW, wave, lane);
#undef IN
#undef SEAM
}

extern "C" void kernel_launch(void* const* d_in, const int* in_sizes, int n_in, void* d_out, int out_size, void* d_ws, size_t ws_size, hipStream_t stream) {
    static int grid = 0;
    if (grid == 0) {
        if (n_in != 14 || ws_size < WS_END) { fprintf(stderr, "kernel_launch: expected 14 inputs and >= %zu bytes of workspace, got %d / %zu\n", (size_t)WS_END, n_in, ws_size); grid = -1; return; }
        int dev = 0, cus = 0, per_cu = 0;
        if (hipGetDevice(&dev) != hipSuccess || hipDeviceGetAttribute(&cus, hipDeviceAttributeMultiprocessorCount, dev) != hipSuccess) { grid = -1; return; }
        if (hipFuncSetAttribute((const void*)hybrid_fwd, hipFuncAttributeMaxDynamicSharedMemorySize, LDS_BYTES) != hipSuccess) { fprintf(stderr, "kernel_launch: hipFuncSetAttribute failed\n"); grid = -1; return; }
        if (hipOccupancyMaxActiveBlocksPerMultiprocessor(&per_cu, (const void*)hybrid_fwd, NWAVES * 64, LDS_BYTES) != hipSuccess || per_cu < 1) fprintf(stderr, "kernel_launch: occupancy query reports %d blocks per CU\n", per_cu);
        (void)hipGetLastError();
        grid = cus;
    }
    if (grid < 0) return;
    (void)hipMemsetAsync((char*)d_ws + WS_CTL, 0, CTL_ZERO_BYTES, stream);
    Args a{};
    for (int i = 0; i < 14; ++i) a.in[i] = (const float*)d_in[i];
    a.out = (float*)d_out; a.ws = (unsigned char*)d_ws;
#if MK_PER_PHASE
    for (int p = 0; p < N_PHASES; ++p) { a.ph_lo = p; a.ph_hi = p + 1; hipLaunchKernelGGL(hybrid_fwd, dim3(grid), dim3(NWAVES * 64), LDS_BYTES, stream, a); }
#else
    a.ph_lo = 0; a.ph_hi = N_PHASES; hipLaunchKernelGGL(hybrid_fwd, dim3(grid), dim3(NWAVES * 64), LDS_BYTES, stream, a);
#endif
}
```
